# Optimizing an MI355X kernel written in HIP

```python
import jax, jax.numpy as jnp
from jax import lax
import numpy as np

D_MODEL = 1024
BATCH = 8
SEQ = 4096
DEPTH = 4

GRID_W = 64
CTX_LEN = 256
N_MIXERS = 3
EPS = 1e-6
D_FF = -(-8 * D_MODEL // (3 * 256)) * 256
D_RNN = (4 * D_MODEL // 3) // 256 * 256
LRU_BLOCK_W = 128
LRU_BLOCKS = D_RNN // LRU_BLOCK_W
LRU_C = 8.0
CONV_W = 4
CONV_LEFT = 2
NA_HEAD_DIM = 64
NA_HEADS = D_MODEL // NA_HEAD_DIM
WIN_ROWS = 8
WIN_COLS = 16
HG_DK = 128
HG_HEADS = D_MODEL // HG_DK
HG_DV = D_MODEL // HG_HEADS
HG_CHUNK = 64

kernel_name = 'hybrid_rglru_natten_hgrn2_prefix_trunk'


def rms_norm(x, g):
    xf = x.astype(jnp.float32)
    y = xf * lax.rsqrt(jnp.mean(xf * xf, axis=-1, keepdims=True) + EPS)
    return (y * g.astype(jnp.float32)).astype(x.dtype)


def modulate(h, shift, scale):
    return h * (1 + scale) + shift


def swiglu(h, w_gu, w_down):
    a, b = jnp.split(h @ w_gu, 2, axis=-1)
    return (jax.nn.silu(a) * b) @ w_down


def short_conv(u, w, b):
    L = u.shape[1]
    up = jnp.pad(u, ((0, 0), (CONV_LEFT, CONV_W - 1 - CONV_LEFT), (0, 0)))
    out = b + w[0] * up[:, 0:L]
    for j in range(1, CONV_W):
        out = out + w[j] * up[:, j:j + L]
    return out


def linear_scan(a, b, h0):
    b = b.at[:, 0].add(a[:, 0] * h0)

    def combine(e1, e2):
        a1, b1 = e1
        a2, b2 = e2
        return a1 * a2, a2 * b1 + b2

    _, h = lax.associative_scan(combine, (a, b), axis=1)
    return h


def flip_seq(t, d):
    return jnp.flip(t, axis=1) if d == 1 else t


def rglru_gates(u, gate_w, gate_b, lam):
    B, L, _ = u.shape
    ub = u.reshape(B, L, LRU_BLOCKS, LRU_BLOCK_W)
    z = jnp.einsum('blnj,gnjk->gblnk', ub, gate_w).reshape(2, B, L, D_RNN)
    z = (z + gate_b[:, None, None, :]).astype(jnp.float32)
    r = jax.nn.sigmoid(z[0])
    i = jax.nn.sigmoid(z[1])
    log_a = -LRU_C * r * jax.nn.softplus(-lam.astype(jnp.float32))
    a = jnp.exp(log_a)
    b = jnp.sqrt(-jnp.expm1(2.0 * log_a)) * i * u.astype(jnp.float32)
    return a, b


def rglru_mixer(h_ctx, h_lat, w_in, conv_w, conv_b, gate_w, gate_b, lam, w_out, need_ctx_out):
    w_gate, w_rec = w_in[:, :D_RNN], w_in[:, D_RNN:]
    u_ctx = short_conv(h_ctx @ w_rec, conv_w, conv_b)
    u_lat = short_conv(h_lat @ w_rec, conv_w, conv_b)
    h0 = jnp.zeros((h_ctx.shape[0], D_RNN), jnp.float32)
    rec_ctx = jnp.zeros(u_ctx.shape, jnp.float32)
    rec_lat = jnp.zeros(u_lat.shape, jnp.float32)
    for d in range(2):
        hc = linear_scan(*rglru_gates(flip_seq(u_ctx, d), gate_w[d], gate_b[d], lam[d]), h0)
        hx = linear_scan(*rglru_gates(flip_seq(u_lat, d), gate_w[d], gate_b[d], lam[d]), hc[:, -1])
        rec_lat = rec_lat + flip_seq(hx, d)
        if need_ctx_out:
            rec_ctx = rec_ctx + flip_seq(hc, d)

    def readout(h, rec):
        return (rec.astype(h.dtype) * jax.nn.gelu(h @ w_gate)) @ w_out

    y_ctx = readout(h_ctx, rec_ctx) if need_ctx_out else None
    return y_ctx, readout(h_lat, rec_lat)


def na_mixer(h_ctx, h_lat, w_qkv, q_g, k_g, rpb, w_o, need_ctx_out):
    B, L, _ = h_lat.shape
    n_ctx = h_ctx.shape[1]
    rows = L // GRID_W
    kr = min(WIN_ROWS, rows)
    n_loc = kr * WIN_COLS
    scale = NA_HEAD_DIM ** -0.5

    def heads(t):
        return t.reshape(t.shape[0], t.shape[1], NA_HEADS, NA_HEAD_DIM)

    kv_c = h_ctx @ w_qkv[:, D_MODEL:]
    k_c = rms_norm(heads(kv_c[..., :D_MODEL]), k_g)
    v_c = heads(kv_c[..., D_MODEL:])

    def grid(t):
        return t.reshape(B, rows, GRID_W, NA_HEADS, NA_HEAD_DIM)

    q, k, v = jnp.split(h_lat @ w_qkv, 3, axis=-1)
    q = grid(rms_norm(heads(q), q_g))
    k = grid(rms_norm(heads(k), k_g))
    v = grid(heads(v))

    col_start = np.clip(np.arange(GRID_W) - WIN_COLS // 2, 0, GRID_W - WIN_COLS)
    col_idx = col_start[:, None] + np.arange(WIN_COLS)[None, :]
    col_off = col_idx - np.arange(GRID_W)[:, None] + (WIN_COLS - 1)

    def one_row(args):
        r, q_r = args
        rs = jnp.clip(r - kr // 2, 0, rows - kr)
        k_n = lax.dynamic_slice_in_dim(k, rs, kr, axis=1)[:, :, col_idx]
        v_n = lax.dynamic_slice_in_dim(v, rs, kr, axis=1)[:, :, col_idx]
        row_off = rs + jnp.arange(kr) - r + (WIN_ROWS - 1)
        bias = rpb[:, row_off[None, :, None], col_off[:, None, :]]
        s_loc = (jnp.einsum('bqhd,brqkhd->bhqrk', q_r, k_n).astype(jnp.float32) * scale
                 + bias.astype(jnp.float32)[None])
        s_ctx = jnp.einsum('bqhd,bchd->bhqc', q_r, k_c).astype(jnp.float32) * scale
        logits = jnp.concatenate([s_loc.reshape(B, NA_HEADS, GRID_W, n_loc), s_ctx], axis=-1)
        p = jax.nn.softmax(logits, axis=-1).astype(v.dtype)
        p_loc = p[..., :n_loc].reshape(B, NA_HEADS, GRID_W, kr, WIN_COLS)
        return (jnp.einsum('bhqrk,brqkhd->bqhd', p_loc, v_n)
                + jnp.einsum('bhqc,bchd->bqhd', p[..., n_loc:], v_c))

    o = lax.map(one_row, (jnp.arange(rows), jnp.moveaxis(q, 1, 0)))
    y_lat = jnp.moveaxis(o, 0, 1).reshape(B, L, D_MODEL) @ w_o
    y_ctx = None
    if need_ctx_out:
        q_c = rms_norm(heads(h_ctx @ w_qkv[:, :D_MODEL]), q_g)
        s = jnp.einsum('bqhd,bkhd->bhqk', q_c, k_c).astype(jnp.float32) * scale
        p = jax.nn.softmax(s, axis=-1).astype(v_c.dtype)
        y_ctx = jnp.einsum('bhqk,bkhd->bqhd', p, v_c).reshape(B, n_ctx, D_MODEL) @ w_o
    return y_ctx, y_lat


def hgrn2_lower_bounds(lb_logits):
    p = jax.nn.softmax(lb_logits.astype(jnp.float32), axis=0)
    return jnp.cumsum(p, axis=0) - p[0:1]


def gla_chunk_scan(q, k, v, log_f, s0):
    B, L, H, _ = q.shape
    n = L // HG_CHUNK

    def chunks(t):
        return jnp.transpose(t.reshape(B, n, HG_CHUNK, H, t.shape[-1]), (1, 0, 3, 2, 4))

    causal = np.tril(np.ones((HG_CHUNK, HG_CHUNK), bool))[None, None, :, :, None]

    def step(S, inp):
        qc, kc, vc, gc = inp
        b = jnp.cumsum(gc, axis=2)
        o = jnp.einsum('bhtk,bhkv->bhtv', qc * jnp.exp(b), S)
        dec = jnp.exp(jnp.where(causal, b[:, :, :, None, :] - b[:, :, None, :, :], -jnp.inf))
        A = jnp.einsum('bhtk,bhsk,bhtsk->bhts', qc, kc, dec)
        o = o + jnp.einsum('bhts,bhsv->bhtv', A, vc)
        b_end = b[:, :, -1:, :]
        S = (jnp.exp(b_end[:, :, 0, :, None]) * S
             + jnp.einsum('bhsk,bhsv->bhkv', kc * jnp.exp(b_end - b), vc))
        return S, o

    S, o = lax.scan(step, s0, (chunks(q), chunks(k), chunks(v), chunks(log_f)))
    return jnp.transpose(o, (1, 0, 3, 2, 4)).reshape(B, L, H, v.shape[-1]), S


def hgrn2_mixer(h_ctx, h_lat, w_in, lb, norm_g, w_o, need_ctx_out):
    lbh = lb.reshape(HG_HEADS, HG_DK)

    def project(h):
        B, L, _ = h.shape

        def heads(t, dd):
            return t.reshape(B, L, HG_HEADS, dd).astype(jnp.float32)

        q, i, g, z_fwd, z_bwd = jnp.split(h @ w_in, 5, axis=-1)
        gates = []
        for z in (z_fwd, z_bwd):
            z = heads(z, HG_DK)
            k = (1 - lbh) * jax.nn.sigmoid(-z)
            log_f = jnp.log(lbh + (1 - lbh) * jax.nn.sigmoid(z))
            gates.append((k, log_f))
        return heads(jax.nn.silu(q), HG_DK), heads(i, HG_DV), g, gates

    q_c, v_c, g_c, gates_c = project(h_ctx)
    q_x, v_x, g_x, gates_x = project(h_lat)
    s0 = jnp.zeros((h_lat.shape[0], HG_HEADS, HG_DK, HG_DV), jnp.float32)
    o_c = jnp.zeros(v_c.shape, jnp.float32)
    o_x = jnp.zeros(v_x.shape, jnp.float32)
    for d in range(2):
        oc, s_ctx = gla_chunk_scan(flip_seq(q_c, d), flip_seq(gates_c[d][0], d), flip_seq(v_c, d),
                                   flip_seq(gates_c[d][1], d), s0)
        ox, _ = gla_chunk_scan(flip_seq(q_x, d), flip_seq(gates_x[d][0], d), flip_seq(v_x, d),
                               flip_seq(gates_x[d][1], d), s_ctx)
        o_x = o_x + flip_seq(ox, d)
        if need_ctx_out:
            o_c = o_c + flip_seq(oc, d)

    def readout(o, g):
        o = rms_norm(o, norm_g).reshape(g.shape).astype(g.dtype)
        return (o * jax.nn.silu(g)) @ w_o

    y_ctx = readout(o_c, g_c) if need_ctx_out else None
    return y_ctx, readout(o_x, g_x)


def setup_inputs(seed: int = 0) -> dict:
    key = jax.random.key(seed)
    ks = iter(jax.random.split(key, 32))

    def nrm(shape, scale):
        return scale * jax.random.normal(next(ks), shape, jnp.float32)

    n_a, n_b, n_c = [len(range(kind, DEPTH, N_MIXERS)) for kind in range(N_MIXERS)]
    u = jax.random.uniform(next(ks), (n_a, 2, D_RNN), jnp.float32, 0.9, 0.999)
    s = u ** (1.0 / LRU_C)
    inp = {}
    inp['x'] = nrm((BATCH, SEQ, D_MODEL), 1.0)
    inp['c'] = nrm((BATCH, D_MODEL), 1.0)
    inp['ctx'] = nrm((BATCH, CTX_LEN, D_MODEL), 1.0)
    inp['c_ctx'] = nrm((D_MODEL,), 1.0)
    inp['mod_w'] = nrm((DEPTH, D_MODEL, 6 * D_MODEL), D_MODEL ** -0.5)
    inp['mod_b'] = nrm((DEPTH, 6 * D_MODEL), 0.02)
    inp['norm_mix_g'] = 1.0 + nrm((DEPTH, D_MODEL), 0.02)
    inp['norm_ffn_g'] = 1.0 + nrm((DEPTH, D_MODEL), 0.02)
    inp['ffn_w_gu'] = nrm((DEPTH, D_MODEL, 2 * D_FF), D_MODEL ** -0.5)
    inp['ffn_w_down'] = nrm((DEPTH, D_FF, D_MODEL), D_FF ** -0.5)
    inp['lru_w_in'] = nrm((n_a, D_MODEL, 2 * D_RNN), D_MODEL ** -0.5)
    inp['lru_conv_w'] = nrm((n_a, CONV_W, D_RNN), CONV_W ** -0.5)
    inp['lru_conv_b'] = nrm((n_a, D_RNN), 0.02)
    inp['lru_gate_w'] = nrm((n_a, 2, 2, LRU_BLOCKS, LRU_BLOCK_W, LRU_BLOCK_W), LRU_BLOCK_W ** -0.5)
    inp['lru_gate_b'] = nrm((n_a, 2, 2, D_RNN), 0.02)
    inp['lru_lambda'] = jnp.log(s) - jnp.log1p(-s)
    inp['lru_w_out'] = nrm((n_a, D_RNN, D_MODEL), D_RNN ** -0.5)
    inp['na_w_qkv'] = nrm((n_b, D_MODEL, 3 * D_MODEL), D_MODEL ** -0.5)
    inp['na_q_norm_g'] = 1.0 + nrm((n_b, NA_HEAD_DIM), 0.02)
    inp['na_k_norm_g'] = 1.0 + nrm((n_b, NA_HEAD_DIM), 0.02)
    inp['na_rpb'] = nrm((n_b, NA_HEADS, 2 * WIN_ROWS - 1, 2 * WIN_COLS - 1), 0.05)
    inp['na_w_o'] = nrm((n_b, D_MODEL, D_MODEL), D_MODEL ** -0.5)
    inp['hg_w_in'] = nrm((n_c, D_MODEL, 5 * D_MODEL), D_MODEL ** -0.5)
    inp['hg_lb_logits'] = nrm((DEPTH, D_MODEL), 0.1)
    inp['hg_norm_g'] = 1.0 + nrm((n_c, HG_DV), 0.02)
    inp['hg_w_o'] = nrm((n_c, D_MODEL, D_MODEL), D_MODEL ** -0.5)
    return inp


def reference(x, c, ctx, c_ctx, mod_w, mod_b, norm_mix_g, norm_ffn_g, ffn_w_gu, ffn_w_down,
              lru_w_in, lru_conv_w, lru_conv_b, lru_gate_w, lru_gate_b, lru_lambda, lru_w_out,
              na_w_qkv, na_q_norm_g, na_k_norm_g, na_rpb, na_w_o,
              hg_w_in, hg_lb_logits, hg_norm_g, hg_w_o):
    lower_bounds = hgrn2_lower_bounds(hg_lb_logits)
    act_lat = jax.nn.silu(c)
    act_ctx = jax.nn.silu(c_ctx)
    for layer in range(DEPTH):
        kind, slot = layer % N_MIXERS, layer // N_MIXERS
        need_ctx = layer < DEPTH - 1
        mx = jnp.split((act_lat @ mod_w[layer] + mod_b[layer])[:, None, :], 6, axis=-1)
        mc = jnp.split(act_ctx @ mod_w[layer] + mod_b[layer], 6, axis=-1)
        hx = modulate(rms_norm(x, norm_mix_g[layer]), mx[0], mx[1])
        hc = modulate(rms_norm(ctx, norm_mix_g[layer]), mc[0], mc[1])
        if kind == 0:
            yc, yx = rglru_mixer(hc, hx, lru_w_in[slot], lru_conv_w[slot], lru_conv_b[slot],
                                 lru_gate_w[slot], lru_gate_b[slot], lru_lambda[slot], lru_w_out[slot],
                                 need_ctx)
        elif kind == 1:
            yc, yx = na_mixer(hc, hx, na_w_qkv[slot], na_q_norm_g[slot], na_k_norm_g[slot],
                              na_rpb[slot], na_w_o[slot], need_ctx)
        else:
            yc, yx = hgrn2_mixer(hc, hx, hg_w_in[slot], lower_bounds[layer], hg_norm_g[slot],
                                 hg_w_o[slot], need_ctx)
        x = x + mx[2] * yx
        x = x + mx[5] * swiglu(modulate(rms_norm(x, norm_ffn_g[layer]), mx[3], mx[4]),
                               ffn_w_gu[layer], ffn_w_down[layer])
        if need_ctx:
            ctx = ctx + mc[2] * yc
            ctx = ctx + mc[5] * swiglu(modulate(rms_norm(ctx, norm_ffn_g[layer]), mc[3], mc[4]),
                                       ffn_w_gu[layer], ffn_w_down[layer])
    return x
```

```cpp
#include <hip/hip_runtime.h>
#include <hip/hip_cooperative_groups.h>
#include <cstdio>
#include <cstring>
namespace cg = cooperative_groups;

typedef unsigned short bf16_t;
typedef short bf16x8 __attribute__((ext_vector_type(8)));
typedef float f32x4 __attribute__((ext_vector_type(4)));
typedef unsigned u32x2 __attribute__((ext_vector_type(2)));
typedef unsigned u32x4 __attribute__((ext_vector_type(4)));

#define T_LAT 32768
#define T_CTX 2048
#define T_ALL 34816
#define DM 1024
#define DFF 2816
#define DRNN 1280
#define NTHREADS 512
#define REP_SCAN 1
#define REP_CHAIN 1
#define REP_ATTN 1
#define REP_P0 1
#define REP_NORM 1
#define EPSV 1e-6f

__device__ __forceinline__ unsigned f2bf(float f) { const __bf16 b = (__bf16)f; return (unsigned)__builtin_bit_cast(unsigned short, b); }
typedef __bf16 bf16x2_t __attribute__((ext_vector_type(2)));
__device__ __forceinline__ unsigned pack2(float lo, float hi) { bf16x2_t v = {(__bf16)lo, (__bf16)hi}; return __builtin_bit_cast(unsigned, v); }
__device__ __forceinline__ float bf2f(unsigned b) { return __uint_as_float(b << 16); }
__device__ __forceinline__ float bflo(unsigned w) { return __uint_as_float(w << 16); }
__device__ __forceinline__ float bfhi(unsigned w) { return __uint_as_float(w & 0xffff0000u); }
__device__ __forceinline__ float frcp(float x) { return __builtin_amdgcn_rcpf(x); }
__device__ __forceinline__ float fexp(float x) { return __builtin_amdgcn_exp2f(x * 1.4426950408889634f); }
__device__ __forceinline__ float fsqrt(float x) { return __builtin_amdgcn_sqrtf(x); }
__device__ __forceinline__ float sigmoidf_(float x) { return frcp(1.0f + fexp(-x)); }
__device__ __forceinline__ float siluf_(float x) { return x * frcp(1.0f + fexp(-x)); }
__device__ __forceinline__ float gelu_tanh(float x) {
    float u = 1.5957691216057308f * (x + 0.044715f * x * x * x);
    return x * frcp(1.0f + fexp(-u));
}
__device__ __forceinline__ bf16x8 mk8(unsigned a, unsigned b, unsigned c, unsigned d) {
    u32x4 v = {a, b, c, d};
    return __builtin_bit_cast(bf16x8, v);
}
__device__ __forceinline__ bf16x8 ld8(const bf16_t* p) { return *reinterpret_cast<const bf16x8*>(p); }
__device__ __forceinline__ f32x4 mfma16(bf16x8 a, bf16x8 b, f32x4 c) {
    return __builtin_amdgcn_mfma_f32_16x16x32_bf16(a, b, c, 0, 0, 0);
}

__device__ __forceinline__ int otid() { int t = threadIdx.x; asm volatile("" : "+v"(t)); return t; }

#define LAS __attribute__((address_space(3)))
#define XB_TMO      128
#define XB_XCNT(j)  (256  + 64 * (j))
#define XB_XSUB(j)  (1280 + 64 * (j))
#define XB_XGEN(j)  (2304 + 64 * (j))
#define XB_TOP      3328
#define XB_TOPGEN   3392
#define XCD_BAR_WORDS 3456
#define XB_SPIN_CAP (1u << 18)
__device__ __forceinline__ unsigned xb_ld(unsigned* p)              { return __hip_atomic_load(p, __ATOMIC_RELAXED, __HIP_MEMORY_SCOPE_AGENT); }
__device__ __forceinline__ unsigned xb_add(unsigned* p, unsigned v) { return __hip_atomic_fetch_add(p, v, __ATOMIC_RELAXED, __HIP_MEMORY_SCOPE_AGENT); }
__device__ __forceinline__ unsigned xb_xcc_id() { return (unsigned)__builtin_amdgcn_s_getreg((3 << 11) | 20) & 0xFu; }
#define XB_SPIN(cond, bar) do { unsigned _sp = 0; while (cond) { __builtin_amdgcn_s_sleep(1); \
    if ((++_sp & 255u) == 0u) { if (xb_ld(&(bar)[XB_TMO])) break; if (_sp > XB_SPIN_CAP) { atomicAdd(&(bar)[XB_TMO], 1u); break; } } } } while (0)
struct XcdBarrier { unsigned* bar; unsigned x; volatile LAS unsigned* st; };
__device__ __forceinline__ XcdBarrier xcd_barrier_post(unsigned* bar, volatile LAS unsigned* st) {
    XcdBarrier b; b.bar = bar; b.x = xb_xcc_id(); b.st = st;
    if (threadIdx.x == 0) (void)xb_add(&bar[XB_XCNT(b.x)], 1u);
    return b;
}
__device__ __forceinline__ void xcd_barrier_complete(unsigned* bar, unsigned x, unsigned& nloc, unsigned& nx) {
    const unsigned G = gridDim.x * gridDim.y * gridDim.z;
    unsigned sum, cnt, mine, sp = 0u;
    for (;;) {
        sum = 0u; cnt = 0u; mine = 0u;
#pragma unroll
        for (unsigned j = 0; j < 16; ++j) { const unsigned c = xb_ld(&bar[XB_XCNT(j)]); sum += c; cnt += (c > 0u) ? 1u : 0u; mine = (j == x) ? c : mine; }
        if (sum == G) break;
        __builtin_amdgcn_s_sleep(1);
        if ((++sp & 255u) == 0u) { if (xb_ld(&bar[XB_TMO])) break; if (sp > XB_SPIN_CAP) { atomicAdd(&bar[XB_TMO], 1u); break; } }
    }
    nloc = mine > 0u ? mine : 1u; nx = cnt > 0u ? cnt : 1u;
}
__device__ __forceinline__ void xcd_barrier(const XcdBarrier& b) {
    asm volatile("s_waitcnt vmcnt(0)" ::: "memory");
    __syncthreads();
    if (threadIdx.x == 0) {
        unsigned* bar = b.bar;
        __builtin_amdgcn_s_waitcnt(0);
        unsigned nloc = b.st[0], nx = b.st[1];
        if (nloc == 0u) { xcd_barrier_complete(bar, b.x, nloc, nx); b.st[0] = nloc; b.st[1] = nx; }
        const unsigned old = xb_add(&bar[XB_XSUB(b.x)], 1u);
        const unsigned gen = old / nloc;
        if (old + 1u == (gen + 1u) * nloc) {
            __builtin_amdgcn_fence(__ATOMIC_RELEASE, "agent");
            asm volatile("s_waitcnt vmcnt(0)" ::: "memory");
            const unsigned og = xb_add(&bar[XB_TOP], 1u);
            const unsigned tg = og / nx;
            if (og + 1u == (tg + 1u) * nx) xb_add(&bar[XB_TOPGEN], 1u);
            else XB_SPIN(xb_ld(&bar[XB_TOPGEN]) == tg, bar);
            __builtin_amdgcn_fence(__ATOMIC_ACQUIRE, "agent");
            xb_add(&bar[XB_XGEN(b.x)], 1u);
            asm volatile("s_waitcnt vmcnt(0)" ::: "memory");
        } else {
            XB_SPIN(xb_ld(&bar[XB_XGEN(b.x)]) == gen, bar);
            __builtin_amdgcn_fence(__ATOMIC_ACQUIRE, "agent");
            asm volatile("s_waitcnt vmcnt(0)" ::: "memory");
        }
    }
    __syncthreads();
}

__device__ __forceinline__ void handoff_signal(unsigned* cnt) {
    asm volatile("s_waitcnt vmcnt(0)" ::: "memory");
    __syncthreads();
    if (threadIdx.x == 0) {
        __builtin_amdgcn_fence(__ATOMIC_RELEASE, "agent");
        asm volatile("s_waitcnt vmcnt(0)" ::: "memory");
        (void)xb_add(cnt, 1u);
    }
}
__device__ __forceinline__ void handoff_wait(unsigned* cnt, unsigned need, unsigned* tmo) {
    if (threadIdx.x == 0) {
        XB_SPIN(xb_ld(cnt) < need, tmo - XB_TMO);
        __builtin_amdgcn_fence(__ATOMIC_ACQUIRE, "agent");
        asm volatile("s_waitcnt vmcnt(0)" ::: "memory");
    }
    __syncthreads();
}

struct ConvJob { const float* src; bf16_t* dst; int K, ld, nrows, mode, nbatch, tile0; long sbs, dbs; };
#define NJOBS 18

struct Params {
    const float *x, *c, *ctx, *c_ctx, *mod_w, *mod_b, *norm_mix_g, *norm_ffn_g;
    const float *lru_conv_w, *lru_conv_b, *lru_gate_b, *lru_lambda;
    const float *na_q_g, *na_k_g, *na_rpb, *hg_lb_logits, *hg_norm_g;
    float* out;
    float* xctx;
    float* modv;
    float* lbv;
    float* dend;
    bf16_t* spare;
    unsigned* bar;
    bf16_t* hbuf;
    char* scr;
    const bf16_t *w_gu[4], *w_dn[4], *w_lin[2], *w_lout[2], *w_gate[2], *w_qkv, *w_nao, *w_hg, *w_hgo;
    ConvJob jobs[NJOBS];
    int total_conv_tiles;
    int conv_tiles_first;
};

__device__ __forceinline__ int colmap(int mode, int n) {
    if (mode == 0) return n;
    if (mode == 1) {
        const int grp = n >> 8, wi = n & 255;
        return (wi < 128) ? grp * 128 + wi : DFF + grp * 128 + (wi - 128);
    }
    if (mode == 2) {
        const int half = n / 2560, r = n - half * 2560;
        if (r >= 2048) return 1024 + half * 512 + (r - 2048);
        const int pn = r >> 8, c = r & 255, bj = c >> 7, wc = (c & 127) >> 5, nn = (c & 31) >> 4, f = c & 15;
        const int ch = half * 512 + pn * 64 + wc * 16 + f, kind = bj * 2 + nn;
        return kind == 0 ? ch : (kind == 1 ? 3072 + ch : (kind == 2 ? 4096 + ch : 2048 + ch));
    }
    if (n >= 2048) return n;
    const int pn = n >> 8, c = n & 255, bj = c >> 7, wc = (c & 127) >> 5, i = c & 31;
    return (pn * 4 + wc) * 64 + bj * 32 + i;
}

struct ConvTileRef { const float* src; bf16_t* dst; int ld, K; };
__device__ __forceinline__ ConvTileRef conv_locate(const Params& p, int t, int tid) {
    int ji = 0;
#pragma unroll 1
    for (int q = 1; q < NJOBS; ++q) if (t >= p.jobs[q].tile0) ji = q;
    const ConvJob& j = p.jobs[ji];
    t -= j.tile0;
    const int tilesK = j.K >> 6, tilesN = j.nrows >> 6, per = tilesK * tilesN;
    const int bt = t / per, r = t - bt * per, tn = r / tilesK, tk = r - tn * tilesK;
    const int n0 = tn * 64, k0 = tk * 64;
    ConvTileRef c;
    c.ld = j.ld; c.K = j.K;
    c.src = j.src + (size_t)bt * j.sbs + (size_t)(k0 + (tid >> 6)) * j.ld + colmap(j.mode, n0 + (tid & 63));
    c.dst = j.dst + (size_t)bt * j.dbs + (size_t)(n0 + (tid >> 3)) * j.K + k0 + (tid & 7) * 8;
    return c;
}

__device__ __forceinline__ void mod_job(const Params& p, int jidx, float* lds) {
    const int tid = otid();
    const int l = jidx / 48, cb = (jidx % 48) * 128;
    float* act = lds;
    float* red = lds + 9216;
    for (int i = tid; i < 9216; i += NTHREADS) {
        int m = i >> 10, k = i & 1023;
        float v = (m < 8) ? p.c[m * 1024 + k] : p.c_ctx[k];
        act[i] = siluf_(v);
    }
    __syncthreads();
    const int cl = tid & 127, ks = tid >> 7, col = cb + cl;
    float acc[9];
#pragma unroll
    for (int m = 0; m < 9; ++m) acc[m] = 0.f;
    const float* wp = p.mod_w + ((size_t)l * 1024 + ks * 256) * 6144 + col;
#pragma unroll 16
    for (int k = 0; k < 256; ++k) {
        float wv = wp[(size_t)k * 6144];
#pragma unroll
        for (int m = 0; m < 9; ++m) acc[m] += act[m * 1024 + ks * 256 + k] * wv;
    }
    if (ks > 0) {
#pragma unroll
        for (int m = 0; m < 9; ++m) red[((ks - 1) * 9 + m) * 128 + cl] = acc[m];
    }
    __syncthreads();
    if (ks == 0) {
        float bv = p.mod_b[l * 6144 + col];
#pragma unroll
        for (int m = 0; m < 9; ++m) {
            float s = acc[m] + red[(0 * 9 + m) * 128 + cl] + red[(1 * 9 + m) * 128 + cl] + red[(2 * 9 + m) * 128 + cl];
            p.modv[((size_t)l * 9 + m) * 6144 + col] = s + bv;
        }
    }
    __syncthreads();
}

__device__ __forceinline__ void conv_range(const Params& p, float* lds, int tbeg, int tend, int bidx, int nblk) {
    const int tid = otid();
    {
        const int n = tid & 63, kr = tid >> 6, nn = tid >> 3, kc = tid & 7;
        float cur[8];
        int t = tbeg + bidx;
        ConvTileRef c{};
        if (t < tend) {
            c = conv_locate(p, t, tid);
#pragma unroll
            for (int ps = 0; ps < 8; ++ps) cur[ps] = c.src[(size_t)ps * 8 * c.ld];
        }
        while (t < tend) {
            const int tn_ = t + nblk;
            float nxt[8];
            ConvTileRef c2{};
            if (tn_ < tend) {
                c2 = conv_locate(p, tn_, tid);
#pragma unroll
                for (int ps = 0; ps < 8; ++ps) nxt[ps] = c2.src[(size_t)ps * 8 * c2.ld];
            }
#pragma unroll
            for (int ps = 0; ps < 8; ++ps) lds[(ps * 8 + kr) * 65 + n] = cur[ps];
            __syncthreads();
            float v[8];
#pragma unroll
            for (int i = 0; i < 8; ++i) v[i] = lds[(kc * 8 + i) * 65 + nn];
            u32x4 o = {pack2(v[0], v[1]), pack2(v[2], v[3]), pack2(v[4], v[5]), pack2(v[6], v[7])};
            *reinterpret_cast<u32x4*>(c.dst) = o;
            __syncthreads();
            if (tn_ < tend) {
#pragma unroll
                for (int ps = 0; ps < 8; ++ps) cur[ps] = nxt[ps];
            }
            c = c2; t = tn_;
        }
    }
}

__device__ __forceinline__ void phase0(const Params& p, char* smem) {
    float* lds = reinterpret_cast<float*>(smem);
    const int tid = otid();
    if (blockIdx.x == gridDim.x - 1) {
        for (int ch = tid; ch < 1024; ch += NTHREADS) {
            float a0 = p.hg_lb_logits[ch], a1 = p.hg_lb_logits[1024 + ch], a2 = p.hg_lb_logits[2048 + ch], a3 = p.hg_lb_logits[3072 + ch];
            float m = fmaxf(fmaxf(a0, a1), fmaxf(a2, a3));
            float e0 = expf(a0 - m), e1 = expf(a1 - m), e2 = expf(a2 - m), e3 = expf(a3 - m);
            p.lbv[ch] = (e1 + e2) / (e0 + e1 + e2 + e3);
        }
    }
    for (int j = blockIdx.x; j < 192; j += gridDim.x) mod_job(p, j, lds);
    conv_range(p, lds, 0, p.conv_tiles_first, blockIdx.x, gridDim.x);
}

__device__ __forceinline__ void normmod_phase(const Params& p, const float* xlat, const float* xctx, int nrows, const float* g, int layer, int shift_i,
                                              int rbeg = 0, int bidx = -1, int nblk = 0) {
    const int tid_ = otid(); const int lane = tid_ & 63, w = tid_ >> 6;
    if (bidx < 0) { bidx = blockIdx.x; nblk = gridDim.x; }
    const int gw = bidx * 8 + w, nw = nblk * 8;
    for (int r = rbeg + gw; r < nrows; r += nw) {
        const float* xp = (r < T_LAT) ? xlat + (size_t)r * DM : xctx + (size_t)(r - T_LAT) * DM;
        const int m = (r < T_LAT) ? (r >> 12) : 8;
        const float* mv = p.modv + ((size_t)layer * 9 + m) * 6144 + shift_i * 1024;
        f32x4 v[4];
        float ss = 0.f;
#pragma unroll
        for (int i = 0; i < 4; ++i) {
            v[i] = *reinterpret_cast<const f32x4*>(xp + (i * 64 + lane) * 4);
            ss += v[i][0] * v[i][0] + v[i][1] * v[i][1] + v[i][2] * v[i][2] + v[i][3] * v[i][3];
        }
#pragma unroll
        for (int o = 32; o >= 1; o >>= 1) ss += __shfl_xor(ss, o);
        const float rstd = rsqrtf(ss * (1.0f / 1024.0f) + EPSV);
        bf16_t* hp = p.hbuf + (size_t)r * DM;
#pragma unroll
        for (int i = 0; i < 4; ++i) {
            const int col = (i * 64 + lane) * 4;
            f32x4 gg = *reinterpret_cast<const f32x4*>(g + col);
            f32x4 sh = *reinterpret_cast<const f32x4*>(mv + col);
            f32x4 sc = *reinterpret_cast<const f32x4*>(mv + 1024 + col);
            float o0 = v[i][0] * rstd * gg[0] * (1.f + sc[0]) + sh[0];
            float o1 = v[i][1] * rstd * gg[1] * (1.f + sc[1]) + sh[1];
            float o2 = v[i][2] * rstd * gg[2] * (1.f + sc[2]) + sh[2];
            float o3 = v[i][3] * rstd * gg[3] * (1.f + sc[3]) + sh[3];
            u32x2 o = {pack2(o0, o1), pack2(o2, o3)};
            *reinterpret_cast<u32x2*>(hp + col) = o;
        }
    }
}

#define GBM 256
#define GBK 64
#define GHALF 128
#define GHTB (GHALF * GBK * 2)
__device__ __forceinline__ int lds_byte(int r, int c) { const int st = (r >> 4) * 2 + (c >> 5), rr = r & 15, cc = c & 31, ob = rr * 64 + cc * 2; return st * 1024 + (ob ^ (((ob >> 9) & 1) << 5)); }
__device__ __forceinline__ void stage_rc(int b, int& R, int& C) { const int st = b / 1024, sb = b % 1024, swz = sb ^ (((sb >> 9) & 1) << 5); R = (st >> 1) * 16 + swz / 64; C = (st & 1) * 32 + (swz % 64) / 2; }
struct Unit { int pm, pn; };
struct StaticOrder {
    int nM, nN, nwg, G, c;
    __device__ void init(int M, int N, int G_, int c_) { nM = M / GBM; nN = N / GBM; nwg = nM * nN; G = G_; c = c_; }
    __device__ bool next(int i, Unit& u) const {
        const long L = (long)i * G + c; if (L >= nwg) return false;
        int wgid = (int)L; { const int q = nwg / 8, r = nwg % 8, xcd = wgid % 8, off = wgid / 8; wgid = (xcd < r ? xcd * (q + 1) : r * (q + 1) + (xcd - r) * q) + off; }
        const int nig = 8 * nN, gid = wgid / nig, fm = gid * 8, gsz = (nM - fm) < 8 ? (nM - fm) : 8;
        u.pm = fm + ((wgid % nig) % gsz); u.pn = (wgid % nig) / gsz; return true;
    }
};

template <class Epi>
__device__ __forceinline__ void gemm_phase(char* smem, const bf16_t* gA, const bf16_t* gBt, int M, int N, int K, const Epi& E, int G = -1, int cidx = 0, int pm0 = 0) {
    LAS unsigned char* lds = (LAS unsigned char*)smem;
    const int tid = otid(), wid = __builtin_amdgcn_readfirstlane(tid >> 6), lane = tid & 63, wr = wid >> 2, wc = wid & 3, fr = lane & 15, fq = lane >> 4;
    const int nt = K / GBK;
    StaticOrder S; if (G < 0) { G = gridDim.x; cidx = blockIdx.x; } S.init(M, N, G, cidx);
    unsigned voff[2];
#pragma unroll
    for (int i = 0; i < 2; ++i) { int R, C; stage_rc(tid * 16 + i * 8192, R, C); voff[i] = (unsigned)(R * K + C) * 2u; }
    const size_t kstep = (size_t)(GBK * 2);
    const size_t hstep = (size_t)GHALF * K * 2;
    const size_t tstep = 2 * hstep;
    const unsigned ldsw = (unsigned)wid * 1024u;
    const int aoff = lds_byte(wr * 64 + fr, fq * 8), boff = lds_byte(wc * 32 + fr, fq * 8);
#define PG8_SA(b, h) (((b) * 2 + (h)) * GHTB)
#define PG8_SB(b, h) ((4 + (b) * 2 + (h)) * GHTB)
#define PG8_STAGE(bufoff, gbase) do { _Pragma("unroll") for (int _i = 0; _i < 2; ++_i) \
        __builtin_amdgcn_global_load_lds((const unsigned*)((const char*)(gbase) + voff[_i]), (LAS unsigned*)(lds + (bufoff) + ldsw + _i * 8192), 16, 0, 0); } while (0)
#define PG8_LDA(dst, b, h) do { _Pragma("unroll") for (int m = 0; m < 4; ++m) _Pragma("unroll") for (int k = 0; k < 2; ++k) dst[m][k] = *(const LAS bf16x8*)(lds + PG8_SA(b, h) + aoff + m * 2048 + k * 1024); } while (0)
#define PG8_LDB(dst, b, h) do { _Pragma("unroll") for (int n = 0; n < 2; ++n) _Pragma("unroll") for (int k = 0; k < 2; ++k) dst[n][k] = *(const LAS bf16x8*)(lds + PG8_SB(b, h) + boff + n * 2048 + k * 1024); } while (0)
#define PG8_MMA(ai, bj, At, Bt) do { __builtin_amdgcn_s_setprio(1); _Pragma("unroll") for (int m = 0; m < 4; ++m) _Pragma("unroll") for (int n = 0; n < 2; ++n) _Pragma("unroll") for (int k = 0; k < 2; ++k) \
        acc[ai][bj][m][n] = Epi::TRANS ? __builtin_amdgcn_mfma_f32_16x16x32_bf16(Bt[n][k], At[m][k], acc[ai][bj][m][n], 0, 0, 0) \
                                       : __builtin_amdgcn_mfma_f32_16x16x32_bf16(At[m][k], Bt[n][k], acc[ai][bj][m][n], 0, 0, 0); __builtin_amdgcn_s_setprio(0); } while (0)
#define PG8_WAIT_V(n) asm volatile("s_waitcnt vmcnt(" #n ")" ::: "memory")
#define PG8_WAIT_L(n) asm volatile("s_waitcnt lgkmcnt(" #n ")" ::: "memory")
#define PG8_BAR __builtin_amdgcn_s_barrier()
#define PG8_SCHED __builtin_amdgcn_sched_barrier(0)
    Unit cur, nxt; int ui = 0;
    if (!S.next(0, cur)) return;
    f32x4 acc[2][2][4][2];
#pragma unroll
    for (int a = 0; a < 2; ++a)
#pragma unroll
        for (int b = 0; b < 2; ++b)
#pragma unroll
            for (int m = 0; m < 4; ++m)
#pragma unroll
                for (int n = 0; n < 2; ++n) acc[a][b][m][n] = (f32x4){0.f, 0.f, 0.f, 0.f};
    bf16x8 At[4][2], B0[2][2], B1[2][2];
    const char* cA = (const char*)gA + (size_t)cur.pm * tstep; const char* cB = (const char*)gBt + (size_t)cur.pn * tstep;
    PG8_STAGE(PG8_SB(0, 0), cB); PG8_STAGE(PG8_SA(0, 0), cA); PG8_STAGE(PG8_SB(0, 1), cB + hstep); PG8_STAGE(PG8_SA(0, 1), cA + hstep);
    if (wr == 1) PG8_BAR;
    PG8_WAIT_V(4); PG8_BAR;
    PG8_STAGE(PG8_SB(1, 0), cB + kstep); PG8_STAGE(PG8_SA(1, 0), cA + kstep); PG8_STAGE(PG8_SB(1, 1), cB + hstep + kstep);
    PG8_WAIT_V(6); PG8_BAR;
    for (;;) {
        const bool has_next = S.next(ui + 1, nxt);
        const char* nA = has_next ? (const char*)gA + (size_t)nxt.pm * tstep : cA; const char* nB = has_next ? (const char*)gBt + (size_t)nxt.pn * tstep : cB;
        for (int t = 0; t < nt; t += 2) {
            const bool last = (t == nt - 2);
            const char* a1 = cA + (size_t)(t + 1) * kstep;
            const char* a2 = last ? nA : cA + (size_t)(t + 2) * kstep; const char* b2 = last ? nB : cB + (size_t)(t + 2) * kstep;
            const char* a3 = a2 + kstep; const char* b3 = b2 + kstep;
            PG8_LDB(B0, 0, 0); PG8_SCHED; PG8_LDA(At, 0, 0); PG8_STAGE(PG8_SA(1, 1), a1 + hstep);
            PG8_WAIT_L(8); PG8_BAR; PG8_WAIT_L(0); PG8_MMA(0, 0, At, B0); PG8_BAR; PG8_SCHED;
            PG8_LDB(B1, 0, 1); PG8_STAGE(PG8_SB(0, 0), b2);
            PG8_BAR; PG8_WAIT_L(0); PG8_MMA(0, 1, At, B1); PG8_BAR;
            PG8_LDA(At, 0, 1); PG8_STAGE(PG8_SA(0, 0), a2);
            PG8_BAR; PG8_WAIT_L(0); PG8_MMA(1, 0, At, B0); PG8_BAR; PG8_SCHED;
            PG8_STAGE(PG8_SB(0, 1), b2 + hstep);
            PG8_WAIT_V(6); PG8_BAR; PG8_MMA(1, 1, At, B1); PG8_BAR;
            PG8_LDB(B0, 1, 0); PG8_SCHED; PG8_LDA(At, 1, 0); PG8_STAGE(PG8_SA(0, 1), a2 + hstep);
            PG8_WAIT_L(8); PG8_BAR; PG8_WAIT_L(0); PG8_MMA(0, 0, At, B0); PG8_BAR; PG8_SCHED;
            PG8_LDB(B1, 1, 1); PG8_STAGE(PG8_SB(1, 0), b3);
            PG8_BAR; PG8_WAIT_L(0); PG8_MMA(0, 1, At, B1); PG8_BAR;
            PG8_LDA(At, 1, 1); PG8_STAGE(PG8_SA(1, 0), a3);
            PG8_BAR; PG8_WAIT_L(0); PG8_MMA(1, 0, At, B0); PG8_BAR; PG8_SCHED;
            PG8_STAGE(PG8_SB(1, 1), b3 + hstep);
            PG8_WAIT_V(6); PG8_BAR; PG8_MMA(1, 1, At, B1); PG8_BAR;
        }
        E(acc, cur.pm + pm0, cur.pn, wr, wc, fr, fq);
        if (!has_next) break;
#pragma unroll
        for (int a = 0; a < 2; ++a)
#pragma unroll
            for (int b = 0; b < 2; ++b)
#pragma unroll
                for (int m = 0; m < 4; ++m)
#pragma unroll
                    for (int n = 0; n < 2; ++n) acc[a][b][m][n] = (f32x4){0.f, 0.f, 0.f, 0.f};
        cur = nxt; cA = nA; cB = nB; ++ui;
    }
    PG8_WAIT_V(0);
    if (wr == 0) PG8_BAR;
    PG8_BAR;
#undef PG8_SA
#undef PG8_SB
#undef PG8_STAGE
#undef PG8_LDA
#undef PG8_LDB
#undef PG8_MMA
#undef PG8_WAIT_V
#undef PG8_WAIT_L
#undef PG8_BAR
#undef PG8_SCHED
}

typedef f32x4 Acc[2][2][4][2];

struct EpiLruIn {
    static constexpr bool TRANS = true;
    bf16_t* gbuf; bf16_t* upre; int mode;
    __device__ __forceinline__ void operator()(Acc& acc, int pm, int pn, int wr, int wc, int fr, int fq) const {
        const bool isg = mode == 0 ? (pn < 5) : (mode == 1);
        bf16_t* base = isg ? gbuf : upre;
        const int cb = ((mode == 0 && !isg) ? pn * 256 - DRNN : pn * 256) + wc * 32 + fq * 4;
#pragma unroll
        for (int ai = 0; ai < 2; ++ai)
#pragma unroll
            for (int m = 0; m < 4; ++m) {
                const size_t ro = (size_t)(pm * 256 + ai * 128 + wr * 64 + m * 16 + fr) * DRNN + cb;
#pragma unroll
                for (int bj = 0; bj < 2; ++bj)
#pragma unroll
                    for (int n = 0; n < 2; ++n) {
                        f32x4 v = acc[ai][bj][m][n];
                        if (isg) { v[0] = gelu_tanh(v[0]); v[1] = gelu_tanh(v[1]); v[2] = gelu_tanh(v[2]); v[3] = gelu_tanh(v[3]); }
                        u32x2 o = {pack2(v[0], v[1]), pack2(v[2], v[3])};
                        *reinterpret_cast<u32x2*>(base + ro + bj * 128 + n * 16) = o;
                    }
            }
    }
};

struct EpiResid {
    static constexpr bool TRANS = true;
    const float* xin_lat; const float* xin_ctx; float* xout_lat; float* xout_ctx; const float* modv_l; int gate_i;
    __device__ __forceinline__ void operator()(Acc& acc, int pm, int pn, int wr, int wc, int fr, int fq) const {
        const int brow = pm * 256;
        const bool lat = brow < T_LAT;
        const float* xin = lat ? xin_lat : xin_ctx;
        float* xout = lat ? xout_lat : xout_ctx;
        const int rsub = lat ? 0 : T_LAT;
        const int mi = lat ? (brow >> 12) : 8;
        const int c0 = pn * 256 + wc * 32 + fq * 4;
        const float* gp = modv_l + (size_t)mi * 6144 + gate_i * 1024 + c0;
#pragma unroll
        for (int bj = 0; bj < 2; ++bj)
#pragma unroll
            for (int n = 0; n < 2; ++n) {
                const f32x4 gv = *reinterpret_cast<const f32x4*>(gp + bj * 128 + n * 16);
#pragma unroll
                for (int ai = 0; ai < 2; ++ai)
#pragma unroll
                    for (int m = 0; m < 4; ++m) {
                        const size_t o = (size_t)(brow + ai * 128 + wr * 64 + m * 16 + fr - rsub) * DM + c0 + bj * 128 + n * 16;
                        const f32x4 xi = *reinterpret_cast<const f32x4*>(xin + o);
                        const f32x4 a = acc[ai][bj][m][n];
                        f32x4 r = {xi[0] + gv[0] * a[0], xi[1] + gv[1] * a[1], xi[2] + gv[2] * a[2], xi[3] + gv[3] * a[3]};
                        *reinterpret_cast<f32x4*>(xout + o) = r;
                    }
            }
    }
};

struct EpiSwiglu {
    static constexpr bool TRANS = true;
    bf16_t* ffh;
    __device__ __forceinline__ void operator()(Acc& acc, int pm, int pn, int wr, int wc, int fr, int fq) const {
        const int hb = pn * 128 + wc * 32 + fq * 4;
#pragma unroll
        for (int ai = 0; ai < 2; ++ai)
#pragma unroll
            for (int m = 0; m < 4; ++m) {
                const size_t ro = (size_t)(pm * 256 + ai * 128 + wr * 64 + m * 16 + fr) * DFF + hb;
#pragma unroll
                for (int n = 0; n < 2; ++n) {
                    const f32x4 a = acc[ai][0][m][n], b = acc[ai][1][m][n];
                    u32x2 o = {pack2(siluf_(a[0]) * b[0], siluf_(a[1]) * b[1]), pack2(siluf_(a[2]) * b[2], siluf_(a[3]) * b[3])};
                    *reinterpret_cast<u32x2*>(ffh + ro + n * 16) = o;
                }
            }
    }
};

__device__ __forceinline__ void store_vT(Acc& acc, bf16_t* vT, int chbase, int pm, int wr, int wc, int fr, int fq) {
#pragma unroll
    for (int bj = 0; bj < 2; ++bj)
#pragma unroll
        for (int n = 0; n < 2; ++n) {
            bf16_t* rowp = vT + (size_t)(chbase + bj * 128 + wc * 32 + n * 16 + fr) * T_ALL + pm * 256 + wr * 64 + fq * 4;
#pragma unroll
            for (int ai = 0; ai < 2; ++ai)
#pragma unroll
                for (int m = 0; m < 4; ++m) {
                    const f32x4 v = acc[ai][bj][m][n];
                    u32x2 o = {pack2(v[0], v[1]), pack2(v[2], v[3])};
                    *reinterpret_cast<u32x2*>(rowp + ai * 128 + m * 16) = o;
                }
        }
}

struct EpiQKV {
    static constexpr bool TRANS = false;
    bf16_t* qk; bf16_t* vT; const float* qg; const float* kg;
    __device__ __forceinline__ void operator()(Acc& acc, int pm, int pn, int wr, int wc, int fr, int fq) const {
        if (pn >= 8) { store_vT(acc, vT, (pn - 8) * 256, pm, wr, wc, fr, fq); return; }
        const int head = pn * 4 + wc;
        const bool isk = head >= 16;
        const float* g = isk ? kg : qg;
        const float sc = isk ? 1.0f : 0.125f;
        float gv[2][2];
#pragma unroll
        for (int bj = 0; bj < 2; ++bj)
#pragma unroll
            for (int n = 0; n < 2; ++n) gv[bj][n] = g[bj * 32 + n * 16 + fr] * sc;
#pragma unroll
        for (int ai = 0; ai < 2; ++ai)
#pragma unroll
            for (int m = 0; m < 4; ++m)
#pragma unroll
                for (int j = 0; j < 4; ++j) {
                    float ss = acc[ai][0][m][0][j] * acc[ai][0][m][0][j] + acc[ai][0][m][1][j] * acc[ai][0][m][1][j] +
                               acc[ai][1][m][0][j] * acc[ai][1][m][0][j] + acc[ai][1][m][1][j] * acc[ai][1][m][1][j];
                    ss += __shfl_xor(ss, 1); ss += __shfl_xor(ss, 2); ss += __shfl_xor(ss, 4); ss += __shfl_xor(ss, 8);
                    const float rs = rsqrtf(ss * (1.0f / 64.0f) + EPSV);
                    bf16_t* rp = qk + (size_t)(pm * 256 + ai * 128 + wr * 64 + m * 16 + fq * 4 + j) * 2048 + head * 64 + fr;
#pragma unroll
                    for (int bj = 0; bj < 2; ++bj)
#pragma unroll
                        for (int n = 0; n < 2; ++n) rp[bj * 32 + n * 16] = (bf16_t)f2bf(acc[ai][bj][m][n][j] * rs * gv[bj][n]);
                }
    }
};

struct EpiHg {
    static constexpr bool TRANS = false;
    bf16_t* qt; bf16_t* kt; bf16_t* sg; bf16_t* vT; float* dend; const float* lbv; int half;
    __device__ __forceinline__ void operator()(Acc& acc, int pm, int pn, int wr, int wc, int fr, int fq) const {
        if (pn >= 8) { store_vT(acc, vT, (pn - 8) * 256, pm, wr, wc, fr, fq); return; }
        const int chl = pn * 64 + wc * 16 + fr, chg = half * 512 + chl;
        const float lb = lbv[chg], oml = 1.f - lb;
#pragma unroll
        for (int ai = 0; ai < 2; ++ai) {
            const int row0 = pm * 256 + ai * 128 + wr * 64;
            float totb = 1.f;
#pragma unroll
            for (int mt = 0; mt < 4; ++mt)
#pragma unroll
                for (int j = 0; j < 4; ++j) {
                    const float sb = frcp(1.f + fexp(-acc[ai][1][mt][0][j]));
                    acc[ai][1][mt][0][j] = sb;
                    totb *= lb + oml * sb;
                }
            totb *= __shfl_xor(totb, 16);
            totb *= __shfl_xor(totb, 32);
            float offf = 1.f, offb = 1.f;
#pragma unroll
            for (int mt = 0; mt < 4; ++mt) {
                float cf[4], cb[4], kf[4], kb[4], fbw[4];
                float rf = 1.f, rb = 1.f;
#pragma unroll
                for (int j = 0; j < 4; ++j) {
                    const float sf = frcp(1.f + fexp(-acc[ai][0][mt][1][j])), sb = acc[ai][1][mt][0][j];
                    const float ff = lb + oml * sf, fb = lb + oml * sb;
                    kf[j] = oml * (1.f - sf); kb[j] = oml * (1.f - sb);
                    rf *= ff; rb *= fb; cf[j] = rf; cb[j] = rb; fbw[j] = fb;
                }
                const float a0 = __shfl(rf, fr), a1 = __shfl(rf, fr + 16), a2 = __shfl(rf, fr + 32), a3 = __shfl(rf, fr + 48);
                const float b0 = __shfl(rb, fr), b1 = __shfl(rb, fr + 16), b2 = __shfl(rb, fr + 32), b3 = __shfl(rb, fr + 48);
                const float pf = offf * (fq > 0 ? a0 : 1.f) * (fq > 1 ? a1 : 1.f) * (fq > 2 ? a2 : 1.f);
                const float pb = offb * (fq > 0 ? b0 : 1.f) * (fq > 1 ? b1 : 1.f) * (fq > 2 ? b2 : 1.f);
                offf *= (a0 * a1) * (a2 * a3);
                offb *= (b0 * b1) * (b2 * b3);
#pragma unroll
                for (int j = 0; j < 4; ++j) {
                    const int row = row0 + mt * 16 + fq * 4 + j;
                    const float Pf = pf * cf[j];
                    const float Pb = totb * fbw[j] * frcp(pb * cb[j]);
                    const float qs = siluf_(acc[ai][0][mt][0][j]);
                    const size_t o0 = ((size_t)row) * 512 + chl, o1 = ((size_t)T_ALL + row) * 512 + chl;
                    qt[o0] = (bf16_t)f2bf(qs * Pf);
                    qt[o1] = (bf16_t)f2bf(qs * Pb);
                    kt[o0] = (bf16_t)f2bf(kf[j] * frcp(Pf));
                    kt[o1] = (bf16_t)f2bf(kb[j] * frcp(Pb));
                    sg[(size_t)row * DM + chg] = (bf16_t)f2bf(siluf_(acc[ai][1][mt][1][j]));
                }
            }
            const int chunk = row0 >> 6;
            if (fq == 0) {
                dend[((size_t)0 * 544 + chunk) * 512 + chl] = offf;
                dend[((size_t)1 * 544 + chunk) * 512 + chl] = totb;
            }
        }
    }
};

__device__ __forceinline__ int ukey(int tk) { return ((tk >> 4) << 2) | (tk & 3); }

__device__ __forceinline__ void lru_scan_phase(const Params& p, int slot, const bf16_t* upre, bf16_t* hf, bf16_t* hb, char* smem, const bf16_t* gateA, bf16_t* gate_out) {
    const int tid = otid(), lane = tid & 63, w = tid >> 6, fr = lane & 15, fq = lane >> 4;
    if (blockIdx.x >= 160) {
        if (slot == 0 && gridDim.x > 160) conv_range(p, reinterpret_cast<float*>(smem), p.conv_tiles_first, p.total_conv_tiles, blockIdx.x - 160, gridDim.x - 160);
        if (gateA != nullptr && gridDim.x > 160) {
            EpiLruIn e{gate_out, nullptr, 1};
            gemm_phase(smem, gateA, p.w_lin[slot], T_LAT, DRNN, DM, e, (int)gridDim.x - 160, (int)blockIdx.x - 160, 0);
        }
        return;
    }
    const int d = blockIdx.x & 1, n = (blockIdx.x >> 1) % 10, b = blockIdx.x / 20;
    const float* convw = p.lru_conv_w + slot * 4 * DRNN;
    const float* convb = p.lru_conv_b + slot * DRNN;
    const bf16_t* gw = p.w_gate[slot];
    const float* gb = p.lru_gate_b + slot * 4 * DRNN;
    const float* lam = p.lru_lambda + slot * 2 * DRNN;
    bf16_t* hout = d ? hb : hf;
    const int ch8 = tid & 15, chn = n * 128 + ch8 * 8;
    float cw[4][8], cbv[8];
    {
        f32x4 b0 = *reinterpret_cast<const f32x4*>(convb + chn), b1 = *reinterpret_cast<const f32x4*>(convb + chn + 4);
        cbv[0] = b0[0]; cbv[1] = b0[1]; cbv[2] = b0[2]; cbv[3] = b0[3]; cbv[4] = b1[0]; cbv[5] = b1[1]; cbv[6] = b1[2]; cbv[7] = b1[3];
#pragma unroll
        for (int j = 0; j < 4; ++j) {
            f32x4 w0 = *reinterpret_cast<const f32x4*>(convw + j * DRNN + chn), w1 = *reinterpret_cast<const f32x4*>(convw + j * DRNN + chn + 4);
            cw[j][0] = w0[0]; cw[j][1] = w0[1]; cw[j][2] = w0[2]; cw[j][3] = w0[3]; cw[j][4] = w1[0]; cw[j][5] = w1[1]; cw[j][6] = w1[2]; cw[j][7] = w1[3];
        }
    }
    const int chw = w * 16 + fr, ch = n * 128 + chw;
    bf16x8 bfr[2][4];
#pragma unroll
    for (int g = 0; g < 2; ++g)
#pragma unroll
        for (int ks = 0; ks < 4; ++ks)
            bfr[g][ks] = ld8(gw + ((size_t)(((d * 2 + g) * 10 + n) * 128 + chw)) * 128 + ks * 32 + fq * 8);
    const float gbr = gb[(d * 2 + 0) * DRNN + ch], gbi = gb[(d * 2 + 1) * DRNN + ch];
    const float sp8 = 8.0f * log1pf(expf(-lam[d * DRNN + ch]));
    float hcar = 0.f;
    u32x4 pre[2][4];
    auto chunk_info = [&](int i, int& seqbase, int& L, int& t0) {
        const int c = d ? (i < 4 ? 3 - i : 71 - i) : i;
        if (c < 4) { seqbase = T_LAT + b * 256; L = 256; t0 = c * 64; }
        else { seqbase = b * 4096; L = 4096; t0 = (c - 4) * 64; }
    };
    auto load_pre = [&](int i) {
        int seqbase, L, t0; chunk_info(i, seqbase, L, t0);
#pragma unroll
        for (int k = 0; k < 2; ++k) {
            const int tk = (tid + k * NTHREADS) >> 4;
#pragma unroll
            for (int j = 0; j < 4; ++j) {
                const int tt = t0 + tk + j - 2;
                u32x4 v = {0u, 0u, 0u, 0u};
                if (tt >= 0 && tt < L) v = *reinterpret_cast<const u32x4*>(upre + (size_t)(seqbase + tt) * DRNN + chn);
                pre[k][j] = v;
            }
        }
    };
    load_pre(0);
#pragma unroll 1
    for (int i = 0; i < 68; ++i) {
        int seqbase, L, t0; chunk_info(i, seqbase, L, t0);
        __syncthreads();
#pragma unroll
        for (int k = 0; k < 2; ++k) {
            const int tk = (tid + k * NTHREADS) >> 4;
            float a[8];
#pragma unroll
            for (int q = 0; q < 8; ++q) a[q] = cbv[q];
#pragma unroll
            for (int j = 0; j < 4; ++j) {
                const u32x4 xv = pre[k][j];
                a[0] += cw[j][0] * bflo(xv[0]); a[1] += cw[j][1] * bfhi(xv[0]); a[2] += cw[j][2] * bflo(xv[1]); a[3] += cw[j][3] * bfhi(xv[1]);
                a[4] += cw[j][4] * bflo(xv[2]); a[5] += cw[j][5] * bfhi(xv[2]); a[6] += cw[j][6] * bflo(xv[3]); a[7] += cw[j][7] * bfhi(xv[3]);
            }
            u32x4 o = {pack2(a[0], a[1]), pack2(a[2], a[3]), pack2(a[4], a[5]), pack2(a[6], a[7])};
            *reinterpret_cast<u32x4*>(smem + tk * 256 + ((ch8 ^ ukey(tk)) * 16)) = o;
        }
        __syncthreads();
        if (i + 1 < 68) load_pre(i + 1);
        f32x4 acc[2][4];
#pragma unroll
        for (int g = 0; g < 2; ++g)
#pragma unroll
            for (int mt = 0; mt < 4; ++mt) acc[g][mt] = (f32x4){0.f, 0.f, 0.f, 0.f};
#pragma unroll
        for (int mt = 0; mt < 4; ++mt) {
            const int tkr = (fr >> 2) * 16 + mt * 4 + (fr & 3);
#pragma unroll
            for (int ks = 0; ks < 4; ++ks) {
                bf16x8 af = *reinterpret_cast<const bf16x8*>(smem + tkr * 256 + (((ks * 4 + fq) ^ ukey(tkr)) * 16));
                acc[0][mt] = mfma16(af, bfr[0][ks], acc[0][mt]);
                acc[1][mt] = mfma16(af, bfr[1][ks], acc[1][mt]);
            }
        }
        float P = 1.f, H = 0.f;
#pragma unroll
        for (int ii = 0; ii < 16; ++ii) {
            const int idxa = ii, idxd = 15 - ii;
            (void)idxa; (void)idxd;
        }
        if (d == 0) {
#pragma unroll
            for (int ii = 0; ii < 16; ++ii) {
                const int mt = ii >> 2, j = ii & 3, tk = fq * 16 + ii;
                const float uval = bf2f(*reinterpret_cast<const bf16_t*>(smem + tk * 256 + (((chw >> 3) ^ ukey(tk)) * 16) + (chw & 7) * 2));
                const float r = sigmoidf_(acc[0][mt][j] + gbr), iv = sigmoidf_(acc[1][mt][j] + gbi);
                const float av = fexp(-sp8 * r);
                const float bv = fsqrt(fmaxf(1.f - av * av, 0.f)) * iv * uval;
                acc[0][mt][j] = av; acc[1][mt][j] = bv;
                H = av * H + bv; P *= av;
            }
        } else {
#pragma unroll
            for (int ii = 15; ii >= 0; --ii) {
                const int mt = ii >> 2, j = ii & 3, tk = fq * 16 + ii;
                const float uval = bf2f(*reinterpret_cast<const bf16_t*>(smem + tk * 256 + (((chw >> 3) ^ ukey(tk)) * 16) + (chw & 7) * 2));
                const float r = sigmoidf_(acc[0][mt][j] + gbr), iv = sigmoidf_(acc[1][mt][j] + gbi);
                const float av = fexp(-sp8 * r);
                const float bv = fsqrt(fmaxf(1.f - av * av, 0.f)) * iv * uval;
                acc[0][mt][j] = av; acc[1][mt][j] = bv;
                H = av * H + bv; P *= av;
            }
        }
        float Ps[4], Hs[4];
#pragma unroll
        for (int q = 0; q < 4; ++q) { Ps[q] = __shfl(P, fr + 16 * q); Hs[q] = __shfl(H, fr + 16 * q); }
        float h = hcar, hall = hcar;
#pragma unroll
        for (int qq = 0; qq < 4; ++qq) {
            const int q = d ? 3 - qq : qq;
            const bool before = d ? (q > fq) : (q < fq);
            if (before) h = Ps[q] * h + Hs[q];
            hall = Ps[q] * hall + Hs[q];
        }
        hcar = hall;
        bf16_t* op = hout + (size_t)(seqbase + t0 + fq * 16) * DRNN + ch;
        if (d == 0) {
#pragma unroll
            for (int ii = 0; ii < 16; ++ii) {
                h = acc[0][ii >> 2][ii & 3] * h + acc[1][ii >> 2][ii & 3];
                op[(size_t)ii * DRNN] = (bf16_t)f2bf(h);
            }
        } else {
#pragma unroll
            for (int ii = 15; ii >= 0; --ii) {
                h = acc[0][ii >> 2][ii & 3] * h + acc[1][ii >> 2][ii & 3];
                op[(size_t)ii * DRNN] = (bf16_t)f2bf(h);
            }
        }
    }
}

__device__ __forceinline__ void lru_combine_phase(bf16_t* hf, const bf16_t* hb, const bf16_t* gbuf, int nrows) {
    const size_t n8 = (size_t)nrows * DRNN / 8;
    for (size_t i = (size_t)blockIdx.x * NTHREADS + otid(); i < n8; i += (size_t)gridDim.x * NTHREADS) {
        const u32x4 a = *reinterpret_cast<const u32x4*>(hf + i * 8), c = *reinterpret_cast<const u32x4*>(hb + i * 8), g = *reinterpret_cast<const u32x4*>(gbuf + i * 8);
        u32x4 o;
#pragma unroll
        for (int q = 0; q < 4; ++q) o[q] = pack2((bflo(a[q]) + bflo(c[q])) * bflo(g[q]), (bfhi(a[q]) + bfhi(c[q])) * bfhi(g[q]));
        *reinterpret_cast<u32x4*>(hf + i * 8) = o;
    }
}

template <bool VLDS>
__device__ __forceinline__ void attn_block(f32x4 (&s)[16], float& m, float& l, f32x4 (&o)[4], const bf16_t* vrow, int tokb, int tokstride, int fq,
                                           LAS unsigned char* vl) {
    float mm = -1e30f;
#pragma unroll
    for (int i = 0; i < 16; ++i) mm = fmaxf(mm, fmaxf(fmaxf(s[i][0], s[i][1]), fmaxf(s[i][2], s[i][3])));
    mm = fmaxf(mm, __shfl_xor(mm, 16));
    mm = fmaxf(mm, __shfl_xor(mm, 32));
    float sum = 0.f;
#pragma unroll
    for (int i = 0; i < 16; ++i)
#pragma unroll
        for (int j = 0; j < 4; ++j) { const float e = fexp(s[i][j] - mm); s[i][j] = e; sum += e; }
    sum += __shfl_xor(sum, 16);
    sum += __shfl_xor(sum, 32);
#pragma unroll
    for (int dt = 0; dt < 4; ++dt) o[dt] = (f32x4){0.f, 0.f, 0.f, 0.f};
#pragma unroll
    for (int grp = 0; grp < 8; ++grp) {
        const bf16x8 pf = mk8(pack2(s[2 * grp][0], s[2 * grp][1]), pack2(s[2 * grp][2], s[2 * grp][3]),
                              pack2(s[2 * grp + 1][0], s[2 * grp + 1][1]), pack2(s[2 * grp + 1][2], s[2 * grp + 1][3]));
        if (VLDS) {
#pragma unroll
            for (int dt = 0; dt < 4; ++dt) o[dt] = mfma16(*(const LAS bf16x8*)(vl + (grp * 4) * 1040 + dt * 256), pf, o[dt]);
            __builtin_amdgcn_sched_barrier(0);
        } else {
            const bf16_t* vp = vrow + tokb + grp * tokstride + fq * 8;
#pragma unroll
            for (int dt = 0; dt < 4; ++dt) o[dt] = mfma16(ld8(vp + (size_t)dt * 16 * T_ALL), pf, o[dt]);
        }
    }
    m = mm; l = sum;
}

#define AT_KC 4112
#define AT_KBYTES (8 * AT_KC)
#define AT_VBYTES (32 * 1040)
__device__ __forceinline__ void attn_phase(const Params& p, const bf16_t* qk, const bf16_t* vT, bf16_t* ob, char* smem) {
    LAS unsigned char* lds = (LAS unsigned char*)smem;
    float* sb = reinterpret_cast<float*>(smem + AT_KBYTES + AT_VBYTES);
    const int tid = otid(), lane = tid & 63, w = __builtin_amdgcn_readfirstlane(tid >> 6), fr = lane & 15, fq = lane >> 4;
    __syncthreads();
    for (int i = tid; i < 16 * 465; i += NTHREADS) sb[i] = p.na_rpb[i];
    const float NEG = -1e30f;
    const int kro = (fr >> 2) * 8 + (fr & 3);
    LAS unsigned char* kl = lds + fq * AT_KC + fr * 16;
    LAS unsigned char* vl = lds + AT_KBYTES + fq * 1040 + fr * 16;
#pragma unroll 1
    for (int vb = blockIdx.x; vb < 256; vb += gridDim.x) {
        const int half = vb & 1, h = (vb >> 1) & 15, b = vb >> 5;
        __syncthreads();
        {
            const int ctok = T_LAT + b * 256;
#pragma unroll
            for (int k = 0; k < 4; ++k) {
                const int ii = w * 4 + k, c = ii >> 2, q = ii & 3;
                const int rho = q * 64 + lane, g = rho >> 5, ts = (rho >> 4) & 1, f = rho & 15;
                const int key = g * 32 + (f >> 2) * 8 + ts * 4 + (f & 3);
                __builtin_amdgcn_global_load_lds((const unsigned*)(qk + (size_t)(ctok + key) * 2048 + 1024 + h * 64 + c * 8),
                                                 (LAS unsigned*)(lds + c * AT_KC + q * 1024), 16, 0, 0);
                const int vc = w * 4 + k;
                __builtin_amdgcn_global_load_lds((const unsigned*)(vT + (size_t)(h * 64 + lane) * T_ALL + ctok + vc * 8),
                                                 (LAS unsigned*)(lds + AT_KBYTES + vc * 1040), 16, 0, 0);
            }
            asm volatile("s_waitcnt vmcnt(0)" ::: "memory");
        }
        __syncthreads();
#pragma unroll 1
        for (int ul = w; ul < 136; ul += 8) {
            const bool isctx = ul >= 128;
            int r = 0, c0 = 0, qtok0;
            if (!isctx) { r = half * 32 + (ul >> 2); c0 = (ul & 3) * 16; qtok0 = b * 4096 + r * 64 + c0; }
            else { qtok0 = T_LAT + b * 256 + (half * 8 + (ul - 128)) * 16; }
            bf16x8 qf[2];
#pragma unroll
            for (int ks = 0; ks < 2; ++ks) qf[ks] = ld8(qk + (size_t)(qtok0 + fr) * 2048 + h * 64 + ks * 32 + fq * 8);
            const bf16_t* vrow = vT + (size_t)(h * 64 + fr) * T_ALL;
            float mL = NEG, lL = 0.f;
            f32x4 oL[4];
#pragma unroll
            for (int dt = 0; dt < 4; ++dt) oL[dt] = (f32x4){0.f, 0.f, 0.f, 0.f};
            if (!isctx) {
                f32x4 s[16];
                const int rs = min(max(r - 4, 0), 56), cst = min(max(c0 - 8, 0), 32);
#pragma unroll
                for (int i = 0; i < 8; ++i)
#pragma unroll
                    for (int ts = 0; ts < 2; ++ts) {
                        const size_t kt = (size_t)(b * 4096 + (rs + i) * 64 + cst + kro + ts * 4) * 2048 + 1024 + h * 64 + fq * 8;
                        f32x4 z = {0.f, 0.f, 0.f, 0.f};
                        z = mfma16(ld8(qk + kt), qf[0], z);
                        z = mfma16(ld8(qk + kt + 32), qf[1], z);
                        s[i * 2 + ts] = z;
                    }
                const int cq = c0 + fr, cs = min(max(cq - 8, 0), 48);
                const float* sbh = sb + h * 465 + (rs - r + 7) * 31;
#pragma unroll
                for (int i = 0; i < 8; ++i)
#pragma unroll
                    for (int ts = 0; ts < 2; ++ts)
#pragma unroll
                        for (int j = 0; j < 4; ++j) {
                            const int kc = cst + fq * 8 + ts * 4 + j;
                            const bool valid = (kc >= cs) && (kc < cs + 16);
                            const int ci = min(max(kc - cq + 15, 0), 30);
                            const float bias = sbh[i * 31 + ci];
                            s[i * 2 + ts][j] = valid ? s[i * 2 + ts][j] + bias : NEG;
                        }
                attn_block<false>(s, mL, lL, oL, vrow, b * 4096 + rs * 64 + cst, 64, fq, vl);
            }
            float mC, lC;
            f32x4 oC[4];
            {
                f32x4 s[16];
#pragma unroll
                for (int g = 0; g < 8; ++g)
#pragma unroll
                    for (int ts = 0; ts < 2; ++ts) {
                        f32x4 z = {0.f, 0.f, 0.f, 0.f};
                        z = mfma16(*(const LAS bf16x8*)(kl + (g * 32 + ts * 16) * 16), qf[0], z);
                        z = mfma16(*(const LAS bf16x8*)(kl + (g * 32 + ts * 16) * 16 + 4 * AT_KC), qf[1], z);
                        s[g * 2 + ts] = z;
                        if (ts == 1 && (g & 1)) __builtin_amdgcn_sched_barrier(0);
                    }
                attn_block<true>(s, mC, lC, oC, vrow, 0, 0, fq, vl);
            }
            const float m = fmaxf(mL, mC);
            const float eL = fexp(mL - m), eC = fexp(mC - m);
            const float inv = frcp(lL * eL + lC * eC);
            const float fL = eL * inv, fC = eC * inv;
#pragma unroll
            for (int dt = 0; dt < 4; ++dt) {
                u32x2 ov = {pack2(oL[dt][0] * fL + oC[dt][0] * fC, oL[dt][1] * fL + oC[dt][1] * fC),
                            pack2(oL[dt][2] * fL + oC[dt][2] * fC, oL[dt][3] * fL + oC[dt][3] * fC)};
                *reinterpret_cast<u32x2*>(ob + (size_t)(qtok0 + fr) * DM + h * 64 + dt * 16 + fq * 4) = ov;
            }
        }
    }
}

#define HC_QK 16640
#define HC_Q0 0
#define HC_K0 (3 * HC_QK)
#define HC_T0 (HC_K0 + 2 * HC_QK)
#define HC_V 8320
#define HC_VDB (HC_V + 512)
#define HC_VD0 (HC_T0 + 2 * 16384)
#define HC_P0 (HC_VD0 + 2 * HC_VDB)
__device__ __forceinline__ void hg_chain_phase(const Params& p, const bf16_t* qt, const bf16_t* kt, const bf16_t* vT, bf16_t* ob, char* smem) {
    if (blockIdx.x >= 256) return;
    LAS unsigned char* lds = (LAS unsigned char*)smem;
    const int tid = otid(), lane = tid & 63, w = __builtin_amdgcn_readfirstlane(tid >> 6), fr = lane & 15, fq = lane >> 4;
    const int chain = blockIdx.x >> 2, dvq = blockIdx.x & 3, dir = chain & 1, hh = (chain >> 1) & 3, b = chain >> 3;
    const bool is_owner = w < 2, is_helper = (w & 2) != 0;
    const int hw = (w & 1) | ((w >> 2) << 1);
    auto row0_of = [&](int i) { const int cidx = dir == 0 ? i : (i < 4 ? 3 - i : 67 - i); return cidx < 4 ? T_LAT + b * 256 + cidx * 64 : b * 4096 + (cidx - 4) * 64; };
    auto issue_qk = [&](int i, int qbuf, int kbuf) {
        const int row0 = row0_of(i);
        const bf16_t* qb = qt + ((size_t)dir * T_ALL + row0 + lane) * 512 + hh * 128;
        const bf16_t* kb = kt + ((size_t)dir * T_ALL + row0 + lane) * 512 + hh * 128;
#pragma unroll
        for (int k = 0; k < 2; ++k) {
            const int c = w + k * 8;
            __builtin_amdgcn_global_load_lds((const unsigned*)(qb + c * 8), (LAS unsigned*)(lds + HC_Q0 + qbuf * HC_QK + c * 1040), 16, 0, 0);
            __builtin_amdgcn_global_load_lds((const unsigned*)(kb + c * 8), (LAS unsigned*)(lds + HC_K0 + kbuf * HC_QK + c * 1040), 16, 0, 0);
        }
    };
    auto issue_vd = [&](int i, int buf) {
        const int row0 = row0_of(i);
        const bf16_t* vb = vT + (size_t)(hh * 128 + dvq * 32 + (lane & 31)) * T_ALL + row0;
        const int base = HC_VD0 + buf * HC_VDB;
        if (lane < 32) __builtin_amdgcn_global_load_lds((const unsigned*)(vb + w * 8), (LAS unsigned*)(lds + base + w * 1040), 16, 0, 0);
        if (tid < 32)
            __builtin_amdgcn_global_load_lds((const unsigned*)(p.dend + ((size_t)dir * 544 + (row0 >> 6)) * 512 + hh * 128 + tid * 4),
                                             (LAS unsigned*)(lds + base + HC_V), 16, 0, 0);
    };
    const int qlane = (fq >> 1) * 1040 + fr * 16 + (fq & 1) * 8;
    const int klane = (fq >> 1) * 1040 + (fr >> 2) * 128 + (fr & 3) * 16 + (fq & 1) * 8;
    const int glane = (fr >> 3) * 1040 + fq * 128 + (fr & 7) * 2;
    const int vlane = fq * 1040 + ((w & 1) * 16 + fr) * 16;
    const int plane = fq * 1040 + fr * 16;
    auto make_p = [&](int qb3, int kb2, int pb, int am, int att) {
        const bool askip = (dir == 0) ? (am == 1 && att < 2) : (am == 0 && att >= 2);
        if (askip) return;
        LAS unsigned char* Qb = lds + HC_Q0 + qb3 * HC_QK;
        LAS unsigned char* Kb = lds + HC_K0 + kb2 * HC_QK;
        f32x4 at[2];
        at[0] = (f32x4){0.f, 0.f, 0.f, 0.f}; at[1] = (f32x4){0.f, 0.f, 0.f, 0.f};
        bf16x8 qa[4];
        LAS unsigned char* qp = Qb + qlane + att * 256;
#pragma unroll
        for (int kk = 0; kk < 4; ++kk) {
            const u32x2 lo = *(const LAS u32x2*)(qp + (kk * 4) * 1040), hi = *(const LAS u32x2*)(qp + (kk * 4 + 2) * 1040);
            qa[kk] = mk8(lo[0], lo[1], hi[0], hi[1]);
        }
        LAS unsigned char* kp = Kb + klane + am * 512;
#pragma unroll
        for (int ts = 0; ts < 2; ++ts)
#pragma unroll
            for (int kk = 0; kk < 4; ++kk) {
                const u32x2 lo = *(const LAS u32x2*)(kp + ts * 64 + (kk * 4) * 1040), hi = *(const LAS u32x2*)(kp + ts * 64 + (kk * 4 + 2) * 1040);
                at[ts] = mfma16(mk8(lo[0], lo[1], hi[0], hi[1]), qa[kk], at[ts]);
            }
        const int t = att * 16 + fr;
        float pv[8];
#pragma unroll
        for (int ts = 0; ts < 2; ++ts)
#pragma unroll
            for (int j = 0; j < 4; ++j) {
                const int sidx = am * 32 + fq * 8 + ts * 4 + j;
                const bool valid = dir == 0 ? (sidx <= t) : (sidx >= t);
                pv[ts * 4 + j] = valid ? at[ts][j] : 0.f;
            }
        u32x4 pw = {pack2(pv[0], pv[1]), pack2(pv[2], pv[3]), pack2(pv[4], pv[5]), pack2(pv[6], pv[7])};
        *(LAS u32x4*)(lds + HC_P0 + pb * 8320 + plane + (am * 4) * 1040 + att * 256) = pw;
    };
    auto make_kt = [&](int kb2, int pb, int hidx) {
        LAS unsigned char* gp = lds + HC_K0 + kb2 * HC_QK + glane;
#pragma unroll
        for (int ff = 0; ff < 4; ++ff) {
            const int f = hidx * 4 + ff, dkt = f >> 1, k2 = f & 1;
            LAS unsigned char* g2 = gp + (dkt * 2) * 1040 + k2 * 512;
            unsigned e[8];
#pragma unroll
            for (int q = 0; q < 8; ++q) e[q] = *(const LAS bf16_t*)(g2 + q * 16);
            u32x4 kf = {e[0] | (e[1] << 16), e[2] | (e[3] << 16), e[4] | (e[5] << 16), e[6] | (e[7] << 16)};
            *(LAS u32x4*)(lds + HC_T0 + pb * 16384 + f * 1024 + lane * 16) = kf;
        }
    };
    f32x4 S[8];
#pragma unroll
    for (int i = 0; i < 8; ++i) S[i] = (f32x4){0.f, 0.f, 0.f, 0.f};
    __syncthreads();
    issue_qk(0, 0, 0); issue_qk(1, 1, 1); issue_vd(0, 0);
    asm volatile("s_waitcnt vmcnt(0)" ::: "memory");
    __syncthreads();
    make_p(0, 0, 0, 0, hw); make_p(0, 0, 0, 1, hw); make_kt(0, 0, hw);
    int q3 = 0;
#pragma unroll 1
    for (int i = 0; i < 68; ++i) {
        const int cur = i & 1;
        const int q3n = (q3 == 2) ? 0 : q3 + 1, q3nn = (q3n == 2) ? 0 : q3n + 1;
        asm volatile("s_waitcnt vmcnt(0)" ::: "memory");
        __syncthreads();
        if (i + 2 < 68) issue_qk(i + 2, q3nn, cur);
        if (i + 1 < 68) issue_vd(i + 1, cur ^ 1);
        if (is_helper) {
            if (i + 1 < 68) { make_p(q3n, cur ^ 1, cur ^ 1, 0, hw); make_p(q3n, cur ^ 1, cur ^ 1, 1, hw); make_kt(cur ^ 1, cur ^ 1, hw); }
        } else if (is_owner) {
            const int row0 = row0_of(i);
            LAS unsigned char* Qb = lds + HC_Q0 + q3 * HC_QK;
            LAS unsigned char* Tb = lds + HC_T0 + cur * 16384 + lane * 16;
            LAS unsigned char* Vb = lds + HC_VD0 + cur * HC_VDB;
            LAS unsigned char* Db = Vb + HC_V;
            LAS unsigned char* Pb = lds + HC_P0 + cur * 8320;
            f32x4 o[4];
            {
                bf16x8 sf[4];
#pragma unroll
                for (int kk = 0; kk < 4; ++kk)
                    sf[kk] = mk8(pack2(S[2 * kk][0], S[2 * kk][1]), pack2(S[2 * kk][2], S[2 * kk][3]),
                                 pack2(S[2 * kk + 1][0], S[2 * kk + 1][1]), pack2(S[2 * kk + 1][2], S[2 * kk + 1][3]));
                LAS unsigned char* qp = Qb + qlane;
#pragma unroll
                for (int tt = 0; tt < 4; ++tt) {
                    o[tt] = (f32x4){0.f, 0.f, 0.f, 0.f};
#pragma unroll
                    for (int kk = 0; kk < 4; ++kk) {
                        const u32x2 lo = *(const LAS u32x2*)(qp + tt * 256 + (kk * 4) * 1040), hi = *(const LAS u32x2*)(qp + tt * 256 + (kk * 4 + 2) * 1040);
                        o[tt] = mfma16(sf[kk], mk8(lo[0], lo[1], hi[0], hi[1]), o[tt]);
                    }
                }
            }
            bf16x8 vf[2];
#pragma unroll
            for (int m = 0; m < 2; ++m) vf[m] = *(const LAS bf16x8*)(Vb + vlane + (m * 4) * 1040);
#pragma unroll
            for (int m = 0; m < 2; ++m)
#pragma unroll
                for (int tt = 0; tt < 4; ++tt) {
                    const bool skip = (dir == 0) ? (m == 1 && tt < 2) : (m == 0 && tt >= 2);
                    if (!skip) {
                        const bf16x8 pf = *(const LAS bf16x8*)(Pb + plane + (m * 4) * 1040 + tt * 256);
                        o[tt] = mfma16(vf[m], pf, o[tt]);
                    }
                }
            bf16_t* op = ob + ((size_t)dir * T_ALL + row0) * 512 + hh * 128 + dvq * 32 + w * 16 + fq * 4;
#pragma unroll
            for (int tt = 0; tt < 4; ++tt) {
                u32x2 ov = {pack2(o[tt][0], o[tt][1]), pack2(o[tt][2], o[tt][3])};
                *reinterpret_cast<u32x2*>(op + (size_t)(tt * 16 + fr) * 512) = ov;
            }
#pragma unroll
            for (int dkt = 0; dkt < 8; ++dkt) {
#pragma unroll
                for (int k2 = 0; k2 < 2; ++k2)
                    S[dkt] = mfma16(*(const LAS bf16x8*)(Tb + (dkt * 2 + k2) * 1024), vf[k2], S[dkt]);
                const f32x4 dd = *(const LAS f32x4*)(Db + dkt * 64 + fq * 16);
                S[dkt][0] *= dd[0]; S[dkt][1] *= dd[1]; S[dkt][2] *= dd[2]; S[dkt][3] *= dd[3];
            }
        }
        q3 = q3n;
    }
}

__device__ __forceinline__ void hg_readout_phase(const Params& p, const bf16_t* ob, bf16_t* sg, int half) {
    const int tid_ = otid(); const int lane = tid_ & 63, w = tid_ >> 6;
    const int gw = blockIdx.x * 8 + w, nw = gridDim.x * 8;
    const float* ng = p.hg_norm_g + (lane & 15) * 8;
    f32x4 g0 = *reinterpret_cast<const f32x4*>(ng), g1 = *reinterpret_cast<const f32x4*>(ng + 4);
    for (int r = gw; r < T_ALL; r += nw) {
        u32x4 a = *reinterpret_cast<const u32x4*>(ob + (size_t)r * 512 + lane * 8);
        u32x4 bq = *reinterpret_cast<const u32x4*>(ob + ((size_t)T_ALL + r) * 512 + lane * 8);
        bf16_t* sp = sg + (size_t)r * DM + half * 512 + lane * 8;
        u32x4 gv = *reinterpret_cast<const u32x4*>(sp);
        float v[8];
#pragma unroll
        for (int i = 0; i < 4; ++i) { v[2 * i] = bflo(a[i]) + bflo(bq[i]); v[2 * i + 1] = bfhi(a[i]) + bfhi(bq[i]); }
        float ss = 0.f;
#pragma unroll
        for (int i = 0; i < 8; ++i) ss += v[i] * v[i];
        ss += __shfl_xor(ss, 1); ss += __shfl_xor(ss, 2); ss += __shfl_xor(ss, 4); ss += __shfl_xor(ss, 8);
        const float rstd = rsqrtf(ss * (1.0f / 128.0f) + EPSV);
        float gg[8] = {g0[0], g0[1], g0[2], g0[3], g1[0], g1[1], g1[2], g1[3]};
        float o[8];
#pragma unroll
        for (int i = 0; i < 4; ++i) {
            o[2 * i] = v[2 * i] * rstd * gg[2 * i] * bflo(gv[i]);
            o[2 * i + 1] = v[2 * i + 1] * rstd * gg[2 * i + 1] * bfhi(gv[i]);
        }
        u32x4 ov = {pack2(o[0], o[1]), pack2(o[2], o[3]), pack2(o[4], o[5]), pack2(o[6], o[7])};
        *reinterpret_cast<u32x4*>(sp) = ov;
    }
}

__global__ void __launch_bounds__(NTHREADS) fwd_megakernel(Params p, int ph0, int ph1) {
    extern __shared__ __attribute__((aligned(16))) char smem[];
    cg::grid_group grid = cg::this_grid();
    int ph = 0;
        volatile LAS unsigned* xst = (volatile LAS unsigned*)((LAS unsigned char*)smem + 150528);
    if (threadIdx.x == 0) { xst[0] = 0u; xst[1] = 0u; xst[2] = 0u; xst[3] = 0u; }
    __syncthreads();
    const XcdBarrier xb = xcd_barrier_post(p.bar, xst);
#define PHASE(...) { if (ph >= ph0 && ph < ph1) { __VA_ARGS__; if (ph + 1 < ph1) { if (ph == 0) grid.sync(); else xcd_barrier(xb); } } ++ph; }

    for (int r_ = 0; r_ < REP_P0; ++r_) PHASE(phase0(p, smem));

    bf16_t* const scr = reinterpret_cast<bf16_t*>(p.scr);
#pragma unroll 1
    for (int layer = 0; layer < 4; ++layer) {
        const int kind = layer % 3, slot = layer / 3;
        const bool need_ctx = layer < 3;
        const int Mall = T_ALL, Mpost = need_ctx ? T_ALL : T_LAT;
        const float* xin_lat = layer == 0 ? p.x : p.out;
        const float* xin_ctx = layer == 0 ? p.ctx : p.xctx;
        const float* modv_l = p.modv + (size_t)layer * 9 * 6144;
        if (layer == 0) PHASE(normmod_phase(p, xin_lat, xin_ctx, Mall, p.norm_mix_g + layer * DM, layer, 0));
        const bf16_t* mixout = nullptr;
        int mixK = 0;
        const bf16_t* wout = nullptr;
        if (kind == 0) {
            const bool ovl = (slot == 1) && gridDim.x > 160;
            bf16_t* hfw = ovl ? scr : p.hbuf;
            bf16_t* hbw = ovl ? p.spare : p.hbuf + (size_t)T_ALL * DRNN;
            bf16_t* gbuf = ovl ? scr + (size_t)T_ALL * DRNN : p.hbuf + (size_t)2 * T_ALL * DRNN;
            bf16_t* upre = ovl ? scr + (size_t)2 * T_ALL * DRNN : p.hbuf + (size_t)3 * T_ALL * DRNN;
            bf16_t* rec = hfw;
            if (ovl) { PHASE({ EpiLruIn e{nullptr, upre, 2}; gemm_phase(smem, p.hbuf, p.w_lin[slot] + (size_t)DRNN * DM, Mall, DRNN, DM, e); }); }
            else { PHASE({ EpiLruIn e{gbuf, upre, 0}; gemm_phase(smem, p.hbuf, p.w_lin[slot], Mall, 2560, DM, e); }); }
            for (int r_ = 0; r_ < REP_SCAN; ++r_) {
            PHASE(lru_scan_phase(p, slot, upre, hfw, hbw, smem, ovl ? p.hbuf : (const bf16_t*)nullptr, gbuf));
            }
            PHASE(lru_combine_phase(hfw, hbw, gbuf, Mpost));
            mixout = rec; mixK = DRNN; wout = p.w_lout[slot];
        } else if (kind == 1) {
            bf16_t* qk = scr;
            bf16_t* vT = scr + (size_t)T_ALL * 2048;
            bf16_t* ob = scr + (size_t)T_ALL * 3072;
            PHASE({ EpiQKV e{qk, vT, p.na_q_g, p.na_k_g}; gemm_phase(smem, p.hbuf, p.w_qkv, Mall, 3072, DM, e); });
            for (int r_ = 0; r_ < REP_ATTN; ++r_) PHASE(attn_phase(p, qk, vT, ob, smem));
            mixout = ob; mixK = DM; wout = p.w_nao;
        } else {
            bf16_t* qt = scr;
            bf16_t* kt = scr + (size_t)T_ALL * 1024;
            bf16_t* vT = scr + (size_t)T_ALL * 2048;
            bf16_t* ob = scr + (size_t)T_ALL * 2560;
            bf16_t* sg = scr + (size_t)T_ALL * 3584;
            for (int half = 0; half < 2; ++half) {
                PHASE({ EpiHg e{qt, kt, sg, vT, p.dend, p.lbv, half}; gemm_phase(smem, p.hbuf, p.w_hg + (size_t)half * 2560 * DM, Mall, 2560, DM, e); });
                for (int r_ = 0; r_ < REP_CHAIN; ++r_) PHASE(hg_chain_phase(p, qt, kt, vT, ob, smem));
                PHASE(hg_readout_phase(p, ob, sg, half));
            }
            mixout = sg; mixK = DM; wout = p.w_hgo;
        }
        const bool split = need_ctx && gridDim.x > 64;
        PHASE({ EpiResid e{xin_lat, xin_ctx, p.out, p.xctx, modv_l, 2}; gemm_phase(smem, mixout, wout, split ? T_LAT : Mpost, DM, mixK, e); });
        if (split) {
            PHASE({
                unsigned* cnt = p.bar + 2 * layer;
                if (blockIdx.x < 32) {
                    EpiResid e{xin_lat, xin_ctx, p.out, p.xctx, modv_l, 2};
                    gemm_phase(smem, mixout + (size_t)T_LAT * mixK, wout, T_CTX, DM, mixK, e, 32, (int)blockIdx.x, 128);
                    handoff_signal(cnt);
                } else {
                    normmod_phase(p, p.out, p.xctx, T_LAT, p.norm_ffn_g + layer * DM, layer, 3, 0, (int)blockIdx.x - 32, (int)gridDim.x - 32);
                    handoff_wait(cnt, 32u, p.bar + XB_TMO);
                    normmod_phase(p, p.out, p.xctx, T_ALL, p.norm_ffn_g + layer * DM, layer, 3, T_LAT, (int)blockIdx.x - 32, (int)gridDim.x - 32);
                }
            });
        } else {
            PHASE(normmod_phase(p, p.out, p.xctx, Mpost, p.norm_ffn_g + layer * DM, layer, 3));
        }
        bf16_t* ffh = scr;
        PHASE({ EpiSwiglu e{ffh}; gemm_phase(smem, p.hbuf, p.w_gu[layer], Mpost, 2 * DFF, DM, e); });
        PHASE({ EpiResid e{p.out, p.xctx, p.out, p.xctx, modv_l, 5}; gemm_phase(smem, ffh, p.w_dn[layer], split ? T_LAT : Mpost, DM, DFF, e); });
        if (layer < 3) {
            const float* gnext = p.norm_mix_g + (layer + 1) * DM;
            if (split) {
                PHASE({
                    unsigned* cnt = p.bar + 2 * layer + 1;
                    if (blockIdx.x < 32) {
                        EpiResid e{p.out, p.xctx, p.out, p.xctx, modv_l, 5};
                        gemm_phase(smem, ffh + (size_t)T_LAT * DFF, p.w_dn[layer], T_CTX, DM, DFF, e, 32, (int)blockIdx.x, 128);
                        handoff_signal(cnt);
                    } else {
                        normmod_phase(p, p.out, p.xctx, T_LAT, gnext, layer + 1, 0, 0, (int)blockIdx.x - 32, (int)gridDim.x - 32);
                        handoff_wait(cnt, 32u, p.bar + XB_TMO);
                        normmod_phase(p, p.out, p.xctx, T_ALL, gnext, layer + 1, 0, T_LAT, (int)blockIdx.x - 32, (int)gridDim.x - 32);
                    }
                });
            } else {
                PHASE(normmod_phase(p, p.out, p.xctx, T_ALL, gnext, layer + 1, 0));
            }
        }
    }
}
#define N_PHASES 35

static inline size_t al256(size_t v) { return (v + 255) & ~(size_t)255; }

extern "C" void kernel_launch(void* const* d_in, const int* in_sizes, int n_in, void* d_out, int out_size, void* d_ws, size_t ws_size,
                              hipStream_t stream) {
    (void)in_sizes; (void)n_in; (void)out_size; (void)ws_size;
    Params p;
    memset(&p, 0, sizeof(p));
    const float* const* in = reinterpret_cast<const float* const*>(d_in);
    p.x = in[0]; p.c = in[1]; p.ctx = in[2]; p.c_ctx = in[3]; p.mod_w = in[4]; p.mod_b = in[5]; p.norm_mix_g = in[6]; p.norm_ffn_g = in[7];
    const float* ffn_w_gu = in[8]; const float* ffn_w_down = in[9]; const float* lru_w_in = in[10];
    p.lru_conv_w = in[11]; p.lru_conv_b = in[12];
    const float* lru_gate_w = in[13];
    p.lru_gate_b = in[14]; p.lru_lambda = in[15];
    const float* lru_w_out = in[16]; const float* na_w_qkv = in[17];
    p.na_q_g = in[18]; p.na_k_g = in[19]; p.na_rpb = in[20];
    const float* na_w_o = in[21]; const float* hg_w_in = in[22];
    p.hg_lb_logits = in[23]; p.hg_norm_g = in[24];
    const float* hg_w_o = in[25];
    p.out = reinterpret_cast<float*>(d_out);

    char* ws = reinterpret_cast<char*>(d_ws);
    size_t off = 0;
    p.xctx = reinterpret_cast<float*>(ws + off); off += al256((size_t)T_CTX * DM * 4);
    p.modv = reinterpret_cast<float*>(ws + off); off += al256((size_t)4 * 9 * 6144 * 4);
    p.lbv = reinterpret_cast<float*>(ws + off); off += al256(1024 * 4);
    p.dend = reinterpret_cast<float*>(ws + off); off += al256((size_t)2 * 544 * 512 * 4);
    p.bar = reinterpret_cast<unsigned*>(ws + off); off += al256((size_t)XCD_BAR_WORDS * 4);
    p.spare = reinterpret_cast<bf16_t*>(ws + off); off += al256((size_t)2 * 2 * 8 * 68 * DRNN * 4);
    bf16_t* wt = reinterpret_cast<bf16_t*>(ws + off);
    size_t woff = 0;
    int nj = 0, tiles = 0;
    auto addjob = [&](const float* src, int K, int ld, int nrows, int mode, int nbatch, long sbs, long dbs) -> const bf16_t* {
        bf16_t* dst = wt + woff;
        ConvJob& j = p.jobs[nj++];
        j.src = src; j.dst = dst; j.K = K; j.ld = ld; j.nrows = nrows; j.mode = mode; j.nbatch = nbatch; j.tile0 = tiles; j.sbs = sbs; j.dbs = dbs;
        tiles += (K / 64) * (nrows / 64) * nbatch;
        woff += (size_t)K * nrows * nbatch;
        return dst;
    };
    p.w_lin[0] = addjob(lru_w_in, DM, 2560, 2560, 0, 1, 0, 0);
    p.w_lout[0] = addjob(lru_w_out, DRNN, DM, DM, 0, 1, 0, 0);
    p.w_gate[0] = addjob(lru_gate_w, 128, 128, 128, 0, 40, 16384, 16384);
    p.w_gu[0] = addjob(ffn_w_gu, DM, 2 * DFF, 2 * DFF, 1, 1, 0, 0);
    p.w_dn[0] = addjob(ffn_w_down, DFF, DM, DM, 0, 1, 0, 0);
    p.conv_tiles_first = tiles;
    for (int l = 1; l < 3; ++l) {
        p.w_gu[l] = addjob(ffn_w_gu + (size_t)l * DM * 2 * DFF, DM, 2 * DFF, 2 * DFF, 1, 1, 0, 0);
        p.w_dn[l] = addjob(ffn_w_down + (size_t)l * DFF * DM, DFF, DM, DM, 0, 1, 0, 0);
    }
    p.w_qkv = addjob(na_w_qkv, DM, 3072, 3072, 3, 1, 0, 0);
    p.w_nao = addjob(na_w_o, DM, DM, DM, 0, 1, 0, 0);
    p.w_hg = addjob(hg_w_in, DM, 5120, 5120, 2, 1, 0, 0);
    p.w_hgo = addjob(hg_w_o, DM, DM, DM, 0, 1, 0, 0);
    p.w_gu[3] = addjob(ffn_w_gu + (size_t)3 * DM * 2 * DFF, DM, 2 * DFF, 2 * DFF, 1, 1, 0, 0);
    p.w_dn[3] = addjob(ffn_w_down + (size_t)3 * DFF * DM, DFF, DM, DM, 0, 1, 0, 0);
    p.w_lin[1] = addjob(lru_w_in + (size_t)DM * 2560, DM, 2560, 2560, 0, 1, 0, 0);
    p.w_lout[1] = addjob(lru_w_out + (size_t)DRNN * DM, DRNN, DM, DM, 0, 1, 0, 0);
    p.w_gate[1] = addjob(lru_gate_w + (size_t)40 * 16384, 128, 128, 128, 0, 40, 16384, 16384);
    p.total_conv_tiles = tiles;
    off += al256(woff * 2);
    p.hbuf = reinterpret_cast<bf16_t*>(ws + off); off += al256((size_t)T_ALL * DM * 2);
    p.scr = ws + off;

    constexpr size_t kDynLds = 150528 + 16;
    static int grid_blocks = 0;
    if (!grid_blocks) {
        int dev = 0, cus = 0, per_cu = 0;
        hipGetDevice(&dev);
        hipDeviceGetAttribute(&cus, hipDeviceAttributeMultiprocessorCount, dev);
        hipFuncSetAttribute((const void*)fwd_megakernel, hipFuncAttributeMaxDynamicSharedMemorySize, (int)kDynLds);
        hipOccupancyMaxActiveBlocksPerMultiprocessor(&per_cu, fwd_megakernel, NTHREADS, kDynLds);
        if (per_cu < 1) per_cu = 1;
        grid_blocks = cus;
        (void)per_cu;
    }
#ifdef MULTI_LAUNCH
    for (int ph = 0; ph < N_PHASES; ++ph) {
        int a = ph, b = ph + 1;
        void* args[] = {&p, &a, &b};
        hipLaunchCooperativeKernel((void*)fwd_megakernel, dim3(grid_blocks), dim3(NTHREADS), args, kDynLds, stream);
    }
#else
    hipMemsetAsync(p.bar, 0, (size_t)XCD_BAR_WORDS * 4, stream);
    int a = 0, b = N_PHASES;
    void* args[] = {&p, &a, &b};
    hipError_t e = hipLaunchCooperativeKernel((void*)fwd_megakernel, dim3(grid_blocks), dim3(NTHREADS), args, kDynLds, stream);
    if (e != hipSuccess) fprintf(stderr, "cooperative launch failed: %s (grid %d)\n", hipGetErrorString(e), grid_blocks);
#endif
}
```

```cpp
#include <hip/hip_runtime.h>
#include <hip/hip_cooperative_groups.h>
#include <cstdio>
#include <cstring>
namespace cg = cooperative_groups;

typedef unsigned short bf16_t;
typedef short bf16x8 __attribute__((ext_vector_type(8)));
typedef float f32x4 __attribute__((ext_vector_type(4)));
typedef unsigned u32x2 __attribute__((ext_vector_type(2)));
typedef unsigned u32x4 __attribute__((ext_vector_type(4)));

#define T_LAT 32768
#define T_CTX 2048
#define T_ALL 34816
#define DM 1024
#define DFF 2816
#define DRNN 1280
#define NTHREADS 512
#define REP_SCAN 1
#define REP_CHAIN 1
#define REP_ATTN 1
#define REP_P0 1
#define REP_NORM 1
#define EPSV 1e-6f

__device__ __forceinline__ unsigned f2bf(float f) { const __bf16 b = (__bf16)f; return (unsigned)__builtin_bit_cast(unsigned short, b); }
typedef __bf16 bf16x2_t __attribute__((ext_vector_type(2)));
__device__ __forceinline__ unsigned pack2(float lo, float hi) { bf16x2_t v = {(__bf16)lo, (__bf16)hi}; return __builtin_bit_cast(unsigned, v); }
__device__ __forceinline__ float bf2f(unsigned b) { return __uint_as_float(b << 16); }
__device__ __forceinline__ float bflo(unsigned w) { return __uint_as_float(w << 16); }
__device__ __forceinline__ float bfhi(unsigned w) { return __uint_as_float(w & 0xffff0000u); }
__device__ __forceinline__ float frcp(float x) { return __builtin_amdgcn_rcpf(x); }
__device__ __forceinline__ float fexp(float x) { return __builtin_amdgcn_exp2f(x * 1.4426950408889634f); }
__device__ __forceinline__ float fsqrt(float x) { return __builtin_amdgcn_sqrtf(x); }
__device__ __forceinline__ float sigmoidf_(float x) { return frcp(1.0f + fexp(-x)); }
__device__ __forceinline__ float siluf_(float x) { return x * frcp(1.0f + fexp(-x)); }
__device__ __forceinline__ float gelu_tanh(float x) {
    float u = 1.5957691216057308f * (x + 0.044715f * x * x * x);
    return x * frcp(1.0f + fexp(-u));
}
__device__ __forceinline__ bf16x8 mk8(unsigned a, unsigned b, unsigned c, unsigned d) {
    u32x4 v = {a, b, c, d};
    return __builtin_bit_cast(bf16x8, v);
}
__device__ __forceinline__ bf16x8 ld8(const bf16_t* p) { return *reinterpret_cast<const bf16x8*>(p); }
__device__ __forceinline__ f32x4 mfma16(bf16x8 a, bf16x8 b, f32x4 c) {
    return __builtin_amdgcn_mfma_f32_16x16x32_bf16(a, b, c, 0, 0, 0);
}

__device__ __forceinline__ int otid() { int t = threadIdx.x; asm volatile("" : "+v"(t)); return t; }

#define LAS __attribute__((address_space(3)))
#define XB_TMO      128
#define XB_XCNT(j)  (256  + 64 * (j))
#define XB_XSUB(j)  (1280 + 64 * (j))
#define XB_XGEN(j)  (2304 + 64 * (j))
#define XB_TOP      3328
#define XB_TOPGEN   3392
#define XCD_BAR_WORDS 3456
#define XB_SPIN_CAP (1u << 18)
__device__ __forceinline__ unsigned xb_ld(unsigned* p)              { return __hip_atomic_load(p, __ATOMIC_RELAXED, __HIP_MEMORY_SCOPE_AGENT); }
__device__ __forceinline__ unsigned xb_add(unsigned* p, unsigned v) { return __hip_atomic_fetch_add(p, v, __ATOMIC_RELAXED, __HIP_MEMORY_SCOPE_AGENT); }
__device__ __forceinline__ unsigned xb_xcc_id() { return (unsigned)__builtin_amdgcn_s_getreg((3 << 11) | 20) & 0xFu; }
#define XB_SPIN(cond, bar) do { unsigned _sp = 0; while (cond) { __builtin_amdgcn_s_sleep(1); \
    if ((++_sp & 255u) == 0u) { if (xb_ld(&(bar)[XB_TMO])) break; if (_sp > XB_SPIN_CAP) { atomicAdd(&(bar)[XB_TMO], 1u); break; } } } } while (0)
struct XcdBarrier { unsigned* bar; unsigned x; volatile LAS unsigned* st; };
__device__ __forceinline__ XcdBarrier xcd_barrier_post(unsigned* bar, volatile LAS unsigned* st) {
    XcdBarrier b; b.bar = bar; b.x = xb_xcc_id(); b.st = st;
    if (threadIdx.x == 0) (void)xb_add(&bar[XB_XCNT(b.x)], 1u);
    return b;
}
__device__ __forceinline__ void xcd_barrier_complete(unsigned* bar, unsigned x, unsigned& nloc, unsigned& nx) {
    const unsigned G = gridDim.x * gridDim.y * gridDim.z;
    unsigned sum, cnt, mine, sp = 0u;
    for (;;) {
        sum = 0u; cnt = 0u; mine = 0u;
#pragma unroll
        for (unsigned j = 0; j < 16; ++j) { const unsigned c = xb_ld(&bar[XB_XCNT(j)]); sum += c; cnt += (c > 0u) ? 1u : 0u; mine = (j == x) ? c : mine; }
        if (sum == G) break;
        __builtin_amdgcn_s_sleep(1);
        if ((++sp & 255u) == 0u) { if (xb_ld(&bar[XB_TMO])) break; if (sp > XB_SPIN_CAP) { atomicAdd(&bar[XB_TMO], 1u); break; } }
    }
    nloc = mine > 0u ? mine : 1u; nx = cnt > 0u ? cnt : 1u;
}
__device__ __forceinline__ void xcd_barrier(const XcdBarrier& b) {
    asm volatile("s_waitcnt vmcnt(0)" ::: "memory");
    __syncthreads();
    if (threadIdx.x == 0) {
        unsigned* bar = b.bar;
        __builtin_amdgcn_s_waitcnt(0);
        unsigned nloc = b.st[0], nx = b.st[1];
        if (nloc == 0u) { xcd_barrier_complete(bar, b.x, nloc, nx); b.st[0] = nloc; b.st[1] = nx; }
        const unsigned old = xb_add(&bar[XB_XSUB(b.x)], 1u);
        const unsigned gen = old / nloc;
        if (old + 1u == (gen + 1u) * nloc) {
            __builtin_amdgcn_fence(__ATOMIC_RELEASE, "agent");
            asm volatile("s_waitcnt vmcnt(0)" ::: "memory");
            const unsigned og = xb_add(&bar[XB_TOP], 1u);
            const unsigned tg = og / nx;
            if (og + 1u == (tg + 1u) * nx) xb_add(&bar[XB_TOPGEN], 1u);
            else XB_SPIN(xb_ld(&bar[XB_TOPGEN]) == tg, bar);
            __builtin_amdgcn_fence(__ATOMIC_ACQUIRE, "agent");
            xb_add(&bar[XB_XGEN(b.x)], 1u);
            asm volatile("s_waitcnt vmcnt(0)" ::: "memory");
        } else {
            XB_SPIN(xb_ld(&bar[XB_XGEN(b.x)]) == gen, bar);
            __builtin_amdgcn_fence(__ATOMIC_ACQUIRE, "agent");
            asm volatile("s_waitcnt vmcnt(0)" ::: "memory");
        }
    }
    __syncthreads();
}

struct ConvJob { const float* src; bf16_t* dst; int K, ld, nrows, mode, nbatch, tile0; long sbs, dbs; };
#define NJOBS 18

struct Params {
    const float *x, *c, *ctx, *c_ctx, *mod_w, *mod_b, *norm_mix_g, *norm_ffn_g;
    const float *lru_conv_w, *lru_conv_b, *lru_gate_b, *lru_lambda;
    const float *na_q_g, *na_k_g, *na_rpb, *hg_lb_logits, *hg_norm_g;
    float* out;
    float* xctx;
    float* modv;
    float* lbv;
    float* dend;
    bf16_t* spare;
    unsigned* bar;
    bf16_t* hbuf;
    char* scr;
    const bf16_t *w_gu[4], *w_dn[4], *w_lin[2], *w_lout[2], *w_gate[2], *w_qkv, *w_nao, *w_hg, *w_hgo;
    ConvJob jobs[NJOBS];
    int total_conv_tiles;
    int conv_tiles_first;
};

__device__ __forceinline__ int colmap(int mode, int n) {
    if (mode == 0) return n;
    if (mode == 1) {
        const int grp = n >> 8, wi = n & 255;
        return (wi < 128) ? grp * 128 + wi : DFF + grp * 128 + (wi - 128);
    }
    if (mode == 2) {
        const int half = n / 2560, r = n - half * 2560;
        if (r >= 2048) return 1024 + half * 512 + (r - 2048);
        const int pn = r >> 8, c = r & 255, bj = c >> 7, wc = (c & 127) >> 5, nn = (c & 31) >> 4, f = c & 15;
        const int ch = half * 512 + pn * 64 + wc * 16 + f, kind = bj * 2 + nn;
        return kind == 0 ? ch : (kind == 1 ? 3072 + ch : (kind == 2 ? 4096 + ch : 2048 + ch));
    }
    if (n >= 2048) return n;
    const int pn = n >> 8, c = n & 255, bj = c >> 7, wc = (c & 127) >> 5, i = c & 31;
    return (pn * 4 + wc) * 64 + bj * 32 + i;
}

struct ConvTileRef { const float* src; bf16_t* dst; int ld, K; };
__device__ __forceinline__ ConvTileRef conv_locate(const Params& p, int t, int tid) {
    int ji = 0;
#pragma unroll 1
    for (int q = 1; q < NJOBS; ++q) if (t >= p.jobs[q].tile0) ji = q;
    const ConvJob& j = p.jobs[ji];
    t -= j.tile0;
    const int tilesK = j.K >> 6, tilesN = j.nrows >> 6, per = tilesK * tilesN;
    const int bt = t / per, r = t - bt * per, tn = r / tilesK, tk = r - tn * tilesK;
    const int n0 = tn * 64, k0 = tk * 64;
    ConvTileRef c;
    c.ld = j.ld; c.K = j.K;
    c.src = j.src + (size_t)bt * j.sbs + (size_t)(k0 + (tid >> 6)) * j.ld + colmap(j.mode, n0 + (tid & 63));
    c.dst = j.dst + (size_t)bt * j.dbs + (size_t)(n0 + (tid >> 3)) * j.K + k0 + (tid & 7) * 8;
    return c;
}

__device__ __forceinline__ void mod_job(const Params& p, int jidx, float* lds) {
    const int tid = otid();
    const int l = jidx / 48, cb = (jidx % 48) * 128;
    float* act = lds;
    float* red = lds + 9216;
    for (int i = tid; i < 9216; i += NTHREADS) {
        int m = i >> 10, k = i & 1023;
        float v = (m < 8) ? p.c[m * 1024 + k] : p.c_ctx[k];
        act[i] = siluf_(v);
    }
    __syncthreads();
    const int cl = tid & 127, ks = tid >> 7, col = cb + cl;
    float acc[9];
#pragma unroll
    for (int m = 0; m < 9; ++m) acc[m] = 0.f;
    const float* wp = p.mod_w + ((size_t)l * 1024 + ks * 256) * 6144 + col;
#pragma unroll 16
    for (int k = 0; k < 256; ++k) {
        float wv = wp[(size_t)k * 6144];
#pragma unroll
        for (int m = 0; m < 9; ++m) acc[m] += act[m * 1024 + ks * 256 + k] * wv;
    }
    if (ks > 0) {
#pragma unroll
        for (int m = 0; m < 9; ++m) red[((ks - 1) * 9 + m) * 128 + cl] = acc[m];
    }
    __syncthreads();
    if (ks == 0) {
        float bv = p.mod_b[l * 6144 + col];
#pragma unroll
        for (int m = 0; m < 9; ++m) {
            float s = acc[m] + red[(0 * 9 + m) * 128 + cl] + red[(1 * 9 + m) * 128 + cl] + red[(2 * 9 + m) * 128 + cl];
            p.modv[((size_t)l * 9 + m) * 6144 + col] = s + bv;
        }
    }
    __syncthreads();
}

__device__ __forceinline__ void conv_range(const Params& p, float* lds, int tbeg, int tend, int bidx, int nblk) {
    const int tid = otid();
    {
        const int n = tid & 63, kr = tid >> 6, nn = tid >> 3, kc = tid & 7;
        float cur[8];
        int t = tbeg + bidx;
        ConvTileRef c{};
        if (t < tend) {
            c = conv_locate(p, t, tid);
#pragma unroll
            for (int ps = 0; ps < 8; ++ps) cur[ps] = c.src[(size_t)ps * 8 * c.ld];
        }
        while (t < tend) {
            const int tn_ = t + nblk;
            float nxt[8];
            ConvTileRef c2{};
            if (tn_ < tend) {
                c2 = conv_locate(p, tn_, tid);
#pragma unroll
                for (int ps = 0; ps < 8; ++ps) nxt[ps] = c2.src[(size_t)ps * 8 * c2.ld];
            }
#pragma unroll
            for (int ps = 0; ps < 8; ++ps) lds[(ps * 8 + kr) * 65 + n] = cur[ps];
            __syncthreads();
            float v[8];
#pragma unroll
            for (int i = 0; i < 8; ++i) v[i] = lds[(kc * 8 + i) * 65 + nn];
            u32x4 o = {pack2(v[0], v[1]), pack2(v[2], v[3]), pack2(v[4], v[5]), pack2(v[6], v[7])};
            *reinterpret_cast<u32x4*>(c.dst) = o;
            __syncthreads();
            if (tn_ < tend) {
#pragma unroll
                for (int ps = 0; ps < 8; ++ps) cur[ps] = nxt[ps];
            }
            c = c2; t = tn_;
        }
    }
}

__device__ __forceinline__ void conv_fast(const Params& p, int tbeg, int tend, int bidx, int nblk) {
    const int tid = otid(), lane = tid & 63, w = tid >> 6;
#pragma unroll 1
    for (int g = 2 * tbeg + bidx * 8 + w; g < 2 * tend; g += nblk * 8) {
        int t = g >> 1;
        const int kh = g & 1;
        int ji = 0;
#pragma unroll 1
        for (int q = 1; q < NJOBS; ++q) if (t >= p.jobs[q].tile0) ji = q;
        const ConvJob& j = p.jobs[ji];
        t -= j.tile0;
        const int tilesK = j.K >> 6, tilesN = j.nrows >> 6, per = tilesK * tilesN;
        const int bt = t / per, r = t - bt * per, tn = r / tilesK, tk = r - tn * tilesK;
        const int n = tn * 64 + lane, k0 = tk * 64 + kh * 32;
        const float* src = j.src + (size_t)bt * j.sbs + (size_t)k0 * j.ld + colmap(j.mode, n);
        const size_t ld = (size_t)j.ld;
        float v[32];
#pragma unroll
        for (int i = 0; i < 32; ++i) v[i] = src[i * ld];
        bf16_t* dst = j.dst + (size_t)bt * j.dbs + (size_t)n * j.K + k0;
#pragma unroll
        for (int q = 0; q < 4; ++q) {
            u32x4 o = {pack2(v[8 * q], v[8 * q + 1]), pack2(v[8 * q + 2], v[8 * q + 3]), pack2(v[8 * q + 4], v[8 * q + 5]), pack2(v[8 * q + 6], v[8 * q + 7])};
            *reinterpret_cast<u32x4*>(dst + 8 * q) = o;
        }
    }
}

__device__ __forceinline__ void phase0(const Params& p, char* smem) {
    float* lds = reinterpret_cast<float*>(smem);
    const int tid = otid();
    if (blockIdx.x == gridDim.x - 1) {
        for (int ch = tid; ch < 1024; ch += NTHREADS) {
            float a0 = p.hg_lb_logits[ch], a1 = p.hg_lb_logits[1024 + ch], a2 = p.hg_lb_logits[2048 + ch], a3 = p.hg_lb_logits[3072 + ch];
            float m = fmaxf(fmaxf(a0, a1), fmaxf(a2, a3));
            float e0 = expf(a0 - m), e1 = expf(a1 - m), e2 = expf(a2 - m), e3 = expf(a3 - m);
            p.lbv[ch] = (e1 + e2) / (e0 + e1 + e2 + e3);
        }
    }
    for (int j = blockIdx.x; j < 192; j += gridDim.x) mod_job(p, j, lds);
    conv_fast(p, 0, p.conv_tiles_first, blockIdx.x, gridDim.x);
}

__device__ __forceinline__ void normmod_phase(const Params& p, const float* xlat, const float* xctx, int nrows, const float* g, int layer, int shift_i,
                                              int rbeg = 0, int bidx = -1, int nblk = 0) {
    const int tid_ = otid(); const int lane = tid_ & 63, w = tid_ >> 6;
    if (bidx < 0) { bidx = blockIdx.x; nblk = gridDim.x; }
    const int gw = bidx * 8 + w, nw = nblk * 8;
    for (int r = rbeg + gw; r < nrows; r += nw) {
        const float* xp = (r < T_LAT) ? xlat + (size_t)r * DM : xctx + (size_t)(r - T_LAT) * DM;
        const int m = (r < T_LAT) ? (r >> 12) : 8;
        const float* mv = p.modv + ((size_t)layer * 9 + m) * 6144 + shift_i * 1024;
        f32x4 v[4];
        float ss = 0.f;
#pragma unroll
        for (int i = 0; i < 4; ++i) {
            v[i] = *reinterpret_cast<const f32x4*>(xp + (i * 64 + lane) * 4);
            ss += v[i][0] * v[i][0] + v[i][1] * v[i][1] + v[i][2] * v[i][2] + v[i][3] * v[i][3];
        }
#pragma unroll
        for (int o = 32; o >= 1; o >>= 1) ss += __shfl_xor(ss, o);
        const float rstd = rsqrtf(ss * (1.0f / 1024.0f) + EPSV);
        bf16_t* hp = p.hbuf + (size_t)r * DM;
#pragma unroll
        for (int i = 0; i < 4; ++i) {
            const int col = (i * 64 + lane) * 4;
            f32x4 gg = *reinterpret_cast<const f32x4*>(g + col);
            f32x4 sh = *reinterpret_cast<const f32x4*>(mv + col);
            f32x4 sc = *reinterpret_cast<const f32x4*>(mv + 1024 + col);
            float o0 = v[i][0] * rstd * gg[0] * (1.f + sc[0]) + sh[0];
            float o1 = v[i][1] * rstd * gg[1] * (1.f + sc[1]) + sh[1];
            float o2 = v[i][2] * rstd * gg[2] * (1.f + sc[2]) + sh[2];
            float o3 = v[i][3] * rstd * gg[3] * (1.f + sc[3]) + sh[3];
            u32x2 o = {pack2(o0, o1), pack2(o2, o3)};
            *reinterpret_cast<u32x2*>(hp + col) = o;
        }
    }
}

#define GBM 256
#define GBK 64
#define GHALF 128
#define GHTB (GHALF * GBK * 2)
__device__ __forceinline__ int lds_byte(int r, int c) { const int st = (r >> 4) * 2 + (c >> 5), rr = r & 15, cc = c & 31, ob = rr * 64 + cc * 2; return st * 1024 + (ob ^ (((ob >> 9) & 1) << 5)); }
__device__ __forceinline__ void stage_rc(int b, int& R, int& C) { const int st = b / 1024, sb = b % 1024, swz = sb ^ (((sb >> 9) & 1) << 5); R = (st >> 1) * 16 + swz / 64; C = (st & 1) * 32 + (swz % 64) / 2; }
struct Unit { int pm, pn; };
struct StaticOrder {
    int nM, nN, nwg, G, c;
    __device__ void init(int M, int N, int G_, int c_) { nM = M / GBM; nN = N / GBM; nwg = nM * nN; G = G_; c = c_; }
    __device__ bool next(int i, Unit& u) const {
        const long L = (long)i * G + c; if (L >= nwg) return false;
        int wgid = (int)L; { const int q = nwg / 8, r = nwg % 8, xcd = wgid % 8, off = wgid / 8; wgid = (xcd < r ? xcd * (q + 1) : r * (q + 1) + (xcd - r) * q) + off; }
        const int nig = 8 * nN, gid = wgid / nig, fm = gid * 8, gsz = (nM - fm) < 8 ? (nM - fm) : 8;
        u.pm = fm + ((wgid % nig) % gsz); u.pn = (wgid % nig) / gsz; return true;
    }
};

template <class Epi>
__device__ __forceinline__ void gemm_phase(char* smem, const bf16_t* gA, const bf16_t* gBt, int M, int N, int K, const Epi& E, int G = -1, int cidx = 0, int pm0 = 0) {
    LAS unsigned char* lds = (LAS unsigned char*)smem;
    const int tid = otid(), wid = __builtin_amdgcn_readfirstlane(tid >> 6), lane = tid & 63, wr = wid >> 2, wc = wid & 3, fr = lane & 15, fq = lane >> 4;
    const int nt = K / GBK;
    StaticOrder S; if (G < 0) { G = gridDim.x; cidx = blockIdx.x; } S.init(M, N, G, cidx);
    unsigned voff[2];
#pragma unroll
    for (int i = 0; i < 2; ++i) { int R, C; stage_rc(tid * 16 + i * 8192, R, C); voff[i] = (unsigned)(R * K + C) * 2u; }
    const size_t kstep = (size_t)(GBK * 2);
    const size_t hstep = (size_t)GHALF * K * 2;
    const size_t tstep = 2 * hstep;
    const unsigned ldsw = (unsigned)wid * 1024u;
    const int aoff = lds_byte(wr * 64 + fr, fq * 8), boff = lds_byte(wc * 32 + fr, fq * 8);
#define PG8_SA(b, h) (((b) * 2 + (h)) * GHTB)
#define PG8_SB(b, h) ((4 + (b) * 2 + (h)) * GHTB)
#define PG8_STAGE(bufoff, gbase) do { _Pragma("unroll") for (int _i = 0; _i < 2; ++_i) \
        __builtin_amdgcn_global_load_lds((const unsigned*)((const char*)(gbase) + voff[_i]), (LAS unsigned*)(lds + (bufoff) + ldsw + _i * 8192), 16, 0, 0); } while (0)
#define PG8_LDA(dst, b, h) do { _Pragma("unroll") for (int m = 0; m < 4; ++m) _Pragma("unroll") for (int k = 0; k < 2; ++k) dst[m][k] = *(const LAS bf16x8*)(lds + PG8_SA(b, h) + aoff + m * 2048 + k * 1024); } while (0)
#define PG8_LDB(dst, b, h) do { _Pragma("unroll") for (int n = 0; n < 2; ++n) _Pragma("unroll") for (int k = 0; k < 2; ++k) dst[n][k] = *(const LAS bf16x8*)(lds + PG8_SB(b, h) + boff + n * 2048 + k * 1024); } while (0)
#define PG8_MMA(ai, bj, At, Bt) do { __builtin_amdgcn_s_setprio(1); _Pragma("unroll") for (int m = 0; m < 4; ++m) _Pragma("unroll") for (int n = 0; n < 2; ++n) _Pragma("unroll") for (int k = 0; k < 2; ++k) \
        acc[ai][bj][m][n] = Epi::TRANS ? __builtin_amdgcn_mfma_f32_16x16x32_bf16(Bt[n][k], At[m][k], acc[ai][bj][m][n], 0, 0, 0) \
                                       : __builtin_amdgcn_mfma_f32_16x16x32_bf16(At[m][k], Bt[n][k], acc[ai][bj][m][n], 0, 0, 0); __builtin_amdgcn_s_setprio(0); } while (0)
#define PG8_WAIT_V(n) asm volatile("s_waitcnt vmcnt(" #n ")" ::: "memory")
#define PG8_WAIT_L(n) asm volatile("s_waitcnt lgkmcnt(" #n ")" ::: "memory")
#define PG8_BAR __builtin_amdgcn_s_barrier()
#define PG8_SCHED __builtin_amdgcn_sched_barrier(0)
    Unit cur, nxt; int ui = 0;
    if (!S.next(0, cur)) return;
    f32x4 acc[2][2][4][2];
#pragma unroll
    for (int a = 0; a < 2; ++a)
#pragma unroll
        for (int b = 0; b < 2; ++b)
#pragma unroll
            for (int m = 0; m < 4; ++m)
#pragma unroll
                for (int n = 0; n < 2; ++n) acc[a][b][m][n] = (f32x4){0.f, 0.f, 0.f, 0.f};
    bf16x8 At[4][2], B0[2][2], B1[2][2];
    const char* cA = (const char*)gA + (size_t)cur.pm * tstep; const char* cB = (const char*)gBt + (size_t)cur.pn * tstep;
    PG8_STAGE(PG8_SB(0, 0), cB); PG8_STAGE(PG8_SA(0, 0), cA); PG8_STAGE(PG8_SB(0, 1), cB + hstep); PG8_STAGE(PG8_SA(0, 1), cA + hstep);
    if (wr == 1) PG8_BAR;
    PG8_WAIT_V(4); PG8_BAR;
    PG8_STAGE(PG8_SB(1, 0), cB + kstep); PG8_STAGE(PG8_SA(1, 0), cA + kstep); PG8_STAGE(PG8_SB(1, 1), cB + hstep + kstep);
    PG8_WAIT_V(6); PG8_BAR;
    for (;;) {
        const bool has_next = S.next(ui + 1, nxt);
        const char* nA = has_next ? (const char*)gA + (size_t)nxt.pm * tstep : cA; const char* nB = has_next ? (const char*)gBt + (size_t)nxt.pn * tstep : cB;
        for (int t = 0; t < nt; t += 2) {
            const bool last = (t == nt - 2);
            const char* a1 = cA + (size_t)(t + 1) * kstep;
            const char* a2 = last ? nA : cA + (size_t)(t + 2) * kstep; const char* b2 = last ? nB : cB + (size_t)(t + 2) * kstep;
            const char* a3 = a2 + kstep; const char* b3 = b2 + kstep;
            PG8_LDB(B0, 0, 0); PG8_SCHED; PG8_LDA(At, 0, 0); PG8_STAGE(PG8_SA(1, 1), a1 + hstep);
            PG8_WAIT_L(8); PG8_BAR; PG8_WAIT_L(0); PG8_MMA(0, 0, At, B0); PG8_BAR; PG8_SCHED;
            PG8_LDB(B1, 0, 1); PG8_STAGE(PG8_SB(0, 0), b2);
            PG8_BAR; PG8_WAIT_L(0); PG8_MMA(0, 1, At, B1); PG8_BAR;
            PG8_LDA(At, 0, 1); PG8_STAGE(PG8_SA(0, 0), a2);
            PG8_BAR; PG8_WAIT_L(0); PG8_MMA(1, 0, At, B0); PG8_BAR; PG8_SCHED;
            PG8_STAGE(PG8_SB(0, 1), b2 + hstep);
            PG8_WAIT_V(6); PG8_BAR; PG8_MMA(1, 1, At, B1); PG8_BAR;
            PG8_LDB(B0, 1, 0); PG8_SCHED; PG8_LDA(At, 1, 0); PG8_STAGE(PG8_SA(0, 1), a2 + hstep);
            PG8_WAIT_L(8); PG8_BAR; PG8_WAIT_L(0); PG8_MMA(0, 0, At, B0); PG8_BAR; PG8_SCHED;
            PG8_LDB(B1, 1, 1); PG8_STAGE(PG8_SB(1, 0), b3);
            PG8_BAR; PG8_WAIT_L(0); PG8_MMA(0, 1, At, B1); PG8_BAR;
            PG8_LDA(At, 1, 1); PG8_STAGE(PG8_SA(1, 0), a3);
            PG8_BAR; PG8_WAIT_L(0); PG8_MMA(1, 0, At, B0); PG8_BAR; PG8_SCHED;
            PG8_STAGE(PG8_SB(1, 1), b3 + hstep);
            PG8_WAIT_V(6); PG8_BAR; PG8_MMA(1, 1, At, B1); PG8_BAR;
        }
        E(acc, cur.pm + pm0, cur.pn, wr, wc, fr, fq);
        if (!has_next) break;
#pragma unroll
        for (int a = 0; a < 2; ++a)
#pragma unroll
            for (int b = 0; b < 2; ++b)
#pragma unroll
                for (int m = 0; m < 4; ++m)
#pragma unroll
                    for (int n = 0; n < 2; ++n) acc[a][b][m][n] = (f32x4){0.f, 0.f, 0.f, 0.f};
        cur = nxt; cA = nA; cB = nB; ++ui;
    }
    PG8_WAIT_V(0);
    if (wr == 0) PG8_BAR;
    PG8_BAR;
#undef PG8_SA
#undef PG8_SB
#undef PG8_STAGE
#undef PG8_LDA
#undef PG8_LDB
#undef PG8_MMA
#undef PG8_WAIT_V
#undef PG8_WAIT_L
#undef PG8_BAR
#undef PG8_SCHED
}

typedef f32x4 Acc[2][2][4][2];

struct EpiLruIn {
    static constexpr bool TRANS = true;
    bf16_t* gbuf; bf16_t* upre; int mode;
    __device__ __forceinline__ void operator()(Acc& acc, int pm, int pn, int wr, int wc, int fr, int fq) const {
        const bool isg = mode == 0 ? (pn < 5) : (mode == 1);
        bf16_t* base = isg ? gbuf : upre;
        const int cb = ((mode == 0 && !isg) ? pn * 256 - DRNN : pn * 256) + wc * 32 + fq * 4;
#pragma unroll
        for (int ai = 0; ai < 2; ++ai)
#pragma unroll
            for (int m = 0; m < 4; ++m) {
                const size_t ro = (size_t)(pm * 256 + ai * 128 + wr * 64 + m * 16 + fr) * DRNN + cb;
#pragma unroll
                for (int bj = 0; bj < 2; ++bj)
#pragma unroll
                    for (int n = 0; n < 2; ++n) {
                        f32x4 v = acc[ai][bj][m][n];
                        if (isg) { v[0] = gelu_tanh(v[0]); v[1] = gelu_tanh(v[1]); v[2] = gelu_tanh(v[2]); v[3] = gelu_tanh(v[3]); }
                        u32x2 o = {pack2(v[0], v[1]), pack2(v[2], v[3])};
                        *reinterpret_cast<u32x2*>(base + ro + bj * 128 + n * 16) = o;
                    }
            }
    }
};

struct EpiResid {
    static constexpr bool TRANS = true;
    const float* xin_lat; const float* xin_ctx; float* xout_lat; float* xout_ctx; const float* modv_l; int gate_i;
    __device__ __forceinline__ void operator()(Acc& acc, int pm, int pn, int wr, int wc, int fr, int fq) const {
        const int brow = pm * 256;
        const bool lat = brow < T_LAT;
        const float* xin = lat ? xin_lat : xin_ctx;
        float* xout = lat ? xout_lat : xout_ctx;
        const int rsub = lat ? 0 : T_LAT;
        const int mi = lat ? (brow >> 12) : 8;
        const int c0 = pn * 256 + wc * 32 + fq * 4;
        const float* gp = modv_l + (size_t)mi * 6144 + gate_i * 1024 + c0;
#pragma unroll
        for (int bj = 0; bj < 2; ++bj)
#pragma unroll
            for (int n = 0; n < 2; ++n) {
                const f32x4 gv = *reinterpret_cast<const f32x4*>(gp + bj * 128 + n * 16);
#pragma unroll
                for (int ai = 0; ai < 2; ++ai)
#pragma unroll
                    for (int m = 0; m < 4; ++m) {
                        const size_t o = (size_t)(brow + ai * 128 + wr * 64 + m * 16 + fr - rsub) * DM + c0 + bj * 128 + n * 16;
                        const f32x4 xi = *reinterpret_cast<const f32x4*>(xin + o);
                        const f32x4 a = acc[ai][bj][m][n];
                        f32x4 r = {xi[0] + gv[0] * a[0], xi[1] + gv[1] * a[1], xi[2] + gv[2] * a[2], xi[3] + gv[3] * a[3]};
                        *reinterpret_cast<f32x4*>(xout + o) = r;
                    }
            }
    }
};

struct EpiSwiglu {
    static constexpr bool TRANS = true;
    bf16_t* ffh;
    __device__ __forceinline__ void operator()(Acc& acc, int pm, int pn, int wr, int wc, int fr, int fq) const {
        const int hb = pn * 128 + wc * 32 + fq * 4;
#pragma unroll
        for (int ai = 0; ai < 2; ++ai)
#pragma unroll
            for (int m = 0; m < 4; ++m) {
                const size_t ro = (size_t)(pm * 256 + ai * 128 + wr * 64 + m * 16 + fr) * DFF + hb;
#pragma unroll
                for (int n = 0; n < 2; ++n) {
                    const f32x4 a = acc[ai][0][m][n], b = acc[ai][1][m][n];
                    u32x2 o = {pack2(siluf_(a[0]) * b[0], siluf_(a[1]) * b[1]), pack2(siluf_(a[2]) * b[2], siluf_(a[3]) * b[3])};
                    *reinterpret_cast<u32x2*>(ffh + ro + n * 16) = o;
                }
            }
    }
};

__device__ __forceinline__ void store_vT(Acc& acc, bf16_t* vT, int chbase, int pm, int wr, int wc, int fr, int fq) {
#pragma unroll
    for (int bj = 0; bj < 2; ++bj)
#pragma unroll
        for (int n = 0; n < 2; ++n) {
            bf16_t* rowp = vT + (size_t)(chbase + bj * 128 + wc * 32 + n * 16 + fr) * T_ALL + pm * 256 + wr * 64 + fq * 4;
#pragma unroll
            for (int ai = 0; ai < 2; ++ai)
#pragma unroll
                for (int m = 0; m < 4; ++m) {
                    const f32x4 v = acc[ai][bj][m][n];
                    u32x2 o = {pack2(v[0], v[1]), pack2(v[2], v[3])};
                    *reinterpret_cast<u32x2*>(rowp + ai * 128 + m * 16) = o;
                }
        }
}

struct EpiQKV {
    static constexpr bool TRANS = false;
    bf16_t* qk; bf16_t* vT; const float* qg; const float* kg;
    __device__ __forceinline__ void operator()(Acc& acc, int pm, int pn, int wr, int wc, int fr, int fq) const {
        if (pn >= 8) { store_vT(acc, vT, (pn - 8) * 256, pm, wr, wc, fr, fq); return; }
        const int head = pn * 4 + wc;
        const bool isk = head >= 16;
        const float* g = isk ? kg : qg;
        const float sc = isk ? 1.0f : 0.125f;
        float gv[2][2];
#pragma unroll
        for (int bj = 0; bj < 2; ++bj)
#pragma unroll
            for (int n = 0; n < 2; ++n) gv[bj][n] = g[bj * 32 + n * 16 + fr] * sc;
#pragma unroll
        for (int ai = 0; ai < 2; ++ai)
#pragma unroll
            for (int m = 0; m < 4; ++m)
#pragma unroll
                for (int j = 0; j < 4; ++j) {
                    float ss = acc[ai][0][m][0][j] * acc[ai][0][m][0][j] + acc[ai][0][m][1][j] * acc[ai][0][m][1][j] +
                               acc[ai][1][m][0][j] * acc[ai][1][m][0][j] + acc[ai][1][m][1][j] * acc[ai][1][m][1][j];
                    ss += __shfl_xor(ss, 1); ss += __shfl_xor(ss, 2); ss += __shfl_xor(ss, 4); ss += __shfl_xor(ss, 8);
                    const float rs = rsqrtf(ss * (1.0f / 64.0f) + EPSV);
                    bf16_t* rp = qk + (size_t)(pm * 256 + ai * 128 + wr * 64 + m * 16 + fq * 4 + j) * 2048 + head * 64 + fr;
#pragma unroll
                    for (int bj = 0; bj < 2; ++bj)
#pragma unroll
                        for (int n = 0; n < 2; ++n) rp[bj * 32 + n * 16] = (bf16_t)f2bf(acc[ai][bj][m][n][j] * rs * gv[bj][n]);
                }
    }
};

struct EpiHg {
    static constexpr bool TRANS = false;
    bf16_t* qt; bf16_t* kt; bf16_t* sg; bf16_t* vT; float* dend; const float* lbv; int half;
    __device__ __forceinline__ void operator()(Acc& acc, int pm, int pn, int wr, int wc, int fr, int fq) const {
        if (pn >= 8) { store_vT(acc, vT, (pn - 8) * 256, pm, wr, wc, fr, fq); return; }
        const int chl = pn * 64 + wc * 16 + fr, chg = half * 512 + chl;
        const float lb = lbv[chg], oml = 1.f - lb;
#pragma unroll
        for (int ai = 0; ai < 2; ++ai) {
            const int row0 = pm * 256 + ai * 128 + wr * 64;
            float totb = 1.f;
#pragma unroll
            for (int mt = 0; mt < 4; ++mt)
#pragma unroll
                for (int j = 0; j < 4; ++j) {
                    const float sb = frcp(1.f + fexp(-acc[ai][1][mt][0][j]));
                    acc[ai][1][mt][0][j] = sb;
                    totb *= lb + oml * sb;
                }
            totb *= __shfl_xor(totb, 16);
            totb *= __shfl_xor(totb, 32);
            float offf = 1.f, offb = 1.f;
#pragma unroll
            for (int mt = 0; mt < 4; ++mt) {
                float cf[4], cb[4], kf[4], kb[4], fbw[4];
                float rf = 1.f, rb = 1.f;
#pragma unroll
                for (int j = 0; j < 4; ++j) {
                    const float sf = frcp(1.f + fexp(-acc[ai][0][mt][1][j])), sb = acc[ai][1][mt][0][j];
                    const float ff = lb + oml * sf, fb = lb + oml * sb;
                    kf[j] = oml * (1.f - sf); kb[j] = oml * (1.f - sb);
                    rf *= ff; rb *= fb; cf[j] = rf; cb[j] = rb; fbw[j] = fb;
                }
                const float a0 = __shfl(rf, fr), a1 = __shfl(rf, fr + 16), a2 = __shfl(rf, fr + 32), a3 = __shfl(rf, fr + 48);
                const float b0 = __shfl(rb, fr), b1 = __shfl(rb, fr + 16), b2 = __shfl(rb, fr + 32), b3 = __shfl(rb, fr + 48);
                const float pf = offf * (fq > 0 ? a0 : 1.f) * (fq > 1 ? a1 : 1.f) * (fq > 2 ? a2 : 1.f);
                const float pb = offb * (fq > 0 ? b0 : 1.f) * (fq > 1 ? b1 : 1.f) * (fq > 2 ? b2 : 1.f);
                offf *= (a0 * a1) * (a2 * a3);
                offb *= (b0 * b1) * (b2 * b3);
#pragma unroll
                for (int j = 0; j < 4; ++j) {
                    const int row = row0 + mt * 16 + fq * 4 + j;
                    const float Pf = pf * cf[j];
                    const float Pb = totb * fbw[j] * frcp(pb * cb[j]);
                    const float qs = siluf_(acc[ai][0][mt][0][j]);
                    const size_t o0 = ((size_t)row) * 512 + chl, o1 = ((size_t)T_ALL + row) * 512 + chl;
                    qt[o0] = (bf16_t)f2bf(qs * Pf);
                    qt[o1] = (bf16_t)f2bf(qs * Pb);
                    kt[o0] = (bf16_t)f2bf(kf[j] * frcp(Pf));
                    kt[o1] = (bf16_t)f2bf(kb[j] * frcp(Pb));
                    sg[(size_t)row * DM + chg] = (bf16_t)f2bf(siluf_(acc[ai][1][mt][1][j]));
                }
            }
            const int chunk = row0 >> 6;
            if (fq == 0) {
                dend[((size_t)0 * 544 + chunk) * 512 + chl] = offf;
                dend[((size_t)1 * 544 + chunk) * 512 + chl] = totb;
            }
        }
    }
};

__device__ __forceinline__ int ukey(int tk) { return ((tk >> 4) << 2) | (tk & 3); }

__device__ __forceinline__ void lru_scan_phase(const Params& p, int slot, const bf16_t* upre, bf16_t* hf, bf16_t* hb, char* smem, const bf16_t* gateA, bf16_t* gate_out) {
    const int tid = otid(), lane = tid & 63, w = tid >> 6, fr = lane & 15, fq = lane >> 4;
    if (blockIdx.x >= 160) {
        if (slot == 0 && gridDim.x > 160) conv_range(p, reinterpret_cast<float*>(smem), p.conv_tiles_first, p.total_conv_tiles, blockIdx.x - 160, gridDim.x - 160);
        if (gateA != nullptr && gridDim.x > 160) {
            EpiLruIn e{gate_out, nullptr, 1};
            gemm_phase(smem, gateA, p.w_lin[slot], T_LAT, DRNN, DM, e, (int)gridDim.x - 160, (int)blockIdx.x - 160, 0);
        }
        return;
    }
    const int d = blockIdx.x & 1, n = (blockIdx.x >> 1) % 10, b = blockIdx.x / 20;
    const float* convw = p.lru_conv_w + slot * 4 * DRNN;
    const float* convb = p.lru_conv_b + slot * DRNN;
    const bf16_t* gw = p.w_gate[slot];
    const float* gb = p.lru_gate_b + slot * 4 * DRNN;
    const float* lam = p.lru_lambda + slot * 2 * DRNN;
    bf16_t* hout = d ? hb : hf;
    const int ch8 = tid & 15, chn = n * 128 + ch8 * 8;
    float cw[4][8], cbv[8];
    {
        f32x4 b0 = *reinterpret_cast<const f32x4*>(convb + chn), b1 = *reinterpret_cast<const f32x4*>(convb + chn + 4);
        cbv[0] = b0[0]; cbv[1] = b0[1]; cbv[2] = b0[2]; cbv[3] = b0[3]; cbv[4] = b1[0]; cbv[5] = b1[1]; cbv[6] = b1[2]; cbv[7] = b1[3];
#pragma unroll
        for (int j = 0; j < 4; ++j) {
            f32x4 w0 = *reinterpret_cast<const f32x4*>(convw + j * DRNN + chn), w1 = *reinterpret_cast<const f32x4*>(convw + j * DRNN + chn + 4);
            cw[j][0] = w0[0]; cw[j][1] = w0[1]; cw[j][2] = w0[2]; cw[j][3] = w0[3]; cw[j][4] = w1[0]; cw[j][5] = w1[1]; cw[j][6] = w1[2]; cw[j][7] = w1[3];
        }
    }
    const int chw = w * 16 + fr, ch = n * 128 + chw;
    bf16x8 bfr[2][4];
#pragma unroll
    for (int g = 0; g < 2; ++g)
#pragma unroll
        for (int ks = 0; ks < 4; ++ks)
            bfr[g][ks] = ld8(gw + ((size_t)(((d * 2 + g) * 10 + n) * 128 + chw)) * 128 + ks * 32 + fq * 8);
    const float gbr = gb[(d * 2 + 0) * DRNN + ch], gbi = gb[(d * 2 + 1) * DRNN + ch];
    const float sp8 = 8.0f * log1pf(expf(-lam[d * DRNN + ch]));
    float hcar = 0.f;
    u32x4 pre[2][4];
    auto chunk_info = [&](int i, int& seqbase, int& L, int& t0) {
        const int c = d ? (i < 4 ? 3 - i : 71 - i) : i;
        if (c < 4) { seqbase = T_LAT + b * 256; L = 256; t0 = c * 64; }
        else { seqbase = b * 4096; L = 4096; t0 = (c - 4) * 64; }
    };
    auto load_pre = [&](int i) {
        int seqbase, L, t0; chunk_info(i, seqbase, L, t0);
#pragma unroll
        for (int k = 0; k < 2; ++k) {
            const int tk = (tid + k * NTHREADS) >> 4;
#pragma unroll
            for (int j = 0; j < 4; ++j) {
                const int tt = t0 + tk + j - 2;
                u32x4 v = {0u, 0u, 0u, 0u};
                if (tt >= 0 && tt < L) v = *reinterpret_cast<const u32x4*>(upre + (size_t)(seqbase + tt) * DRNN + chn);
                pre[k][j] = v;
            }
        }
    };
    load_pre(0);
#pragma unroll 1
    for (int i = 0; i < 68; ++i) {
        int seqbase, L, t0; chunk_info(i, seqbase, L, t0);
        __syncthreads();
#pragma unroll
        for (int k = 0; k < 2; ++k) {
            const int tk = (tid + k * NTHREADS) >> 4;
            float a[8];
#pragma unroll
            for (int q = 0; q < 8; ++q) a[q] = cbv[q];
#pragma unroll
            for (int j = 0; j < 4; ++j) {
                const u32x4 xv = pre[k][j];
                a[0] += cw[j][0] * bflo(xv[0]); a[1] += cw[j][1] * bfhi(xv[0]); a[2] += cw[j][2] * bflo(xv[1]); a[3] += cw[j][3] * bfhi(xv[1]);
                a[4] += cw[j][4] * bflo(xv[2]); a[5] += cw[j][5] * bfhi(xv[2]); a[6] += cw[j][6] * bflo(xv[3]); a[7] += cw[j][7] * bfhi(xv[3]);
            }
            u32x4 o = {pack2(a[0], a[1]), pack2(a[2], a[3]), pack2(a[4], a[5]), pack2(a[6], a[7])};
            *reinterpret_cast<u32x4*>(smem + tk * 256 + ((ch8 ^ ukey(tk)) * 16)) = o;
        }
        __syncthreads();
        if (i + 1 < 68) load_pre(i + 1);
        f32x4 acc[2][4];
#pragma unroll
        for (int g = 0; g < 2; ++g)
#pragma unroll
            for (int mt = 0; mt < 4; ++mt) acc[g][mt] = (f32x4){0.f, 0.f, 0.f, 0.f};
#pragma unroll
        for (int mt = 0; mt < 4; ++mt) {
            const int tkr = (fr >> 2) * 16 + mt * 4 + (fr & 3);
#pragma unroll
            for (int ks = 0; ks < 4; ++ks) {
                bf16x8 af = *reinterpret_cast<const bf16x8*>(smem + tkr * 256 + (((ks * 4 + fq) ^ ukey(tkr)) * 16));
                acc[0][mt] = mfma16(af, bfr[0][ks], acc[0][mt]);
                acc[1][mt] = mfma16(af, bfr[1][ks], acc[1][mt]);
            }
        }
        float P = 1.f, H = 0.f;
#pragma unroll
        for (int ii = 0; ii < 16; ++ii) {
            const int idxa = ii, idxd = 15 - ii;
            (void)idxa; (void)idxd;
        }
        if (d == 0) {
#pragma unroll
            for (int ii = 0; ii < 16; ++ii) {
                const int mt = ii >> 2, j = ii & 3, tk = fq * 16 + ii;
                const float uval = bf2f(*reinterpret_cast<const bf16_t*>(smem + tk * 256 + (((chw >> 3) ^ ukey(tk)) * 16) + (chw & 7) * 2));
                const float r = sigmoidf_(acc[0][mt][j] + gbr), iv = sigmoidf_(acc[1][mt][j] + gbi);
                const float av = fexp(-sp8 * r);
                const float bv = fsqrt(fmaxf(1.f - av * av, 0.f)) * iv * uval;
                acc[0][mt][j] = av; acc[1][mt][j] = bv;
                H = av * H + bv; P *= av;
            }
        } else {
#pragma unroll
            for (int ii = 15; ii >= 0; --ii) {
                const int mt = ii >> 2, j = ii & 3, tk = fq * 16 + ii;
                const float uval = bf2f(*reinterpret_cast<const bf16_t*>(smem + tk * 256 + (((chw >> 3) ^ ukey(tk)) * 16) + (chw & 7) * 2));
                const float r = sigmoidf_(acc[0][mt][j] + gbr), iv = sigmoidf_(acc[1][mt][j] + gbi);
                const float av = fexp(-sp8 * r);
                const float bv = fsqrt(fmaxf(1.f - av * av, 0.f)) * iv * uval;
                acc[0][mt][j] = av; acc[1][mt][j] = bv;
                H = av * H + bv; P *= av;
            }
        }
        float Ps[4], Hs[4];
#pragma unroll
        for (int q = 0; q < 4; ++q) { Ps[q] = __shfl(P, fr + 16 * q); Hs[q] = __shfl(H, fr + 16 * q); }
        float h = hcar, hall = hcar;
#pragma unroll
        for (int qq = 0; qq < 4; ++qq) {
            const int q = d ? 3 - qq : qq;
            const bool before = d ? (q > fq) : (q < fq);
            if (before) h = Ps[q] * h + Hs[q];
            hall = Ps[q] * hall + Hs[q];
        }
        hcar = hall;
        bf16_t* op = hout + (size_t)(seqbase + t0 + fq * 16) * DRNN + ch;
        if (d == 0) {
#pragma unroll
            for (int ii = 0; ii < 16; ++ii) {
                h = acc[0][ii >> 2][ii & 3] * h + acc[1][ii >> 2][ii & 3];
                op[(size_t)ii * DRNN] = (bf16_t)f2bf(h);
            }
        } else {
#pragma unroll
            for (int ii = 15; ii >= 0; --ii) {
                h = acc[0][ii >> 2][ii & 3] * h + acc[1][ii >> 2][ii & 3];
                op[(size_t)ii * DRNN] = (bf16_t)f2bf(h);
            }
        }
    }
}

__device__ __forceinline__ void lru_combine_phase(bf16_t* hf, const bf16_t* hb, const bf16_t* gbuf, int nrows) {
    const size_t n8 = (size_t)nrows * DRNN / 8;
    for (size_t i = (size_t)blockIdx.x * NTHREADS + otid(); i < n8; i += (size_t)gridDim.x * NTHREADS) {
        const u32x4 a = *reinterpret_cast<const u32x4*>(hf + i * 8), c = *reinterpret_cast<const u32x4*>(hb + i * 8), g = *reinterpret_cast<const u32x4*>(gbuf + i * 8);
        u32x4 o;
#pragma unroll
        for (int q = 0; q < 4; ++q) o[q] = pack2((bflo(a[q]) + bflo(c[q])) * bflo(g[q]), (bfhi(a[q]) + bfhi(c[q])) * bfhi(g[q]));
        *reinterpret_cast<u32x4*>(hf + i * 8) = o;
    }
}

template <bool VLDS>
__device__ __forceinline__ void attn_block(f32x4 (&s)[16], float& m, float& l, f32x4 (&o)[4], const bf16_t* vrow, int tokb, int tokstride, int fq,
                                           LAS unsigned char* vl) {
    float mm = -1e30f;
#pragma unroll
    for (int i = 0; i < 16; ++i) mm = fmaxf(mm, fmaxf(fmaxf(s[i][0], s[i][1]), fmaxf(s[i][2], s[i][3])));
    mm = fmaxf(mm, __shfl_xor(mm, 16));
    mm = fmaxf(mm, __shfl_xor(mm, 32));
    float sum = 0.f;
#pragma unroll
    for (int i = 0; i < 16; ++i)
#pragma unroll
        for (int j = 0; j < 4; ++j) { const float e = fexp(s[i][j] - mm); s[i][j] = e; sum += e; }
    sum += __shfl_xor(sum, 16);
    sum += __shfl_xor(sum, 32);
#pragma unroll
    for (int dt = 0; dt < 4; ++dt) o[dt] = (f32x4){0.f, 0.f, 0.f, 0.f};
#pragma unroll
    for (int grp = 0; grp < 8; ++grp) {
        const bf16x8 pf = mk8(pack2(s[2 * grp][0], s[2 * grp][1]), pack2(s[2 * grp][2], s[2 * grp][3]),
                              pack2(s[2 * grp + 1][0], s[2 * grp + 1][1]), pack2(s[2 * grp + 1][2], s[2 * grp + 1][3]));
        if (VLDS) {
#pragma unroll
            for (int dt = 0; dt < 4; ++dt) o[dt] = mfma16(*(const LAS bf16x8*)(vl + (grp * 4) * 1040 + dt * 256), pf, o[dt]);
            __builtin_amdgcn_sched_barrier(0);
        } else {
            const bf16_t* vp = vrow + tokb + grp * tokstride + fq * 8;
#pragma unroll
            for (int dt = 0; dt < 4; ++dt) o[dt] = mfma16(ld8(vp + (size_t)dt * 16 * T_ALL), pf, o[dt]);
        }
    }
    m = mm; l = sum;
}

#define AT_KC 4112
#define AT_KBYTES (8 * AT_KC)
#define AT_VBYTES (32 * 1040)
__device__ __forceinline__ void attn_phase(const Params& p, const bf16_t* qk, const bf16_t* vT, bf16_t* ob, char* smem) {
    LAS unsigned char* lds = (LAS unsigned char*)smem;
    float* sb = reinterpret_cast<float*>(smem + AT_KBYTES + AT_VBYTES);
    const int tid = otid(), lane = tid & 63, w = __builtin_amdgcn_readfirstlane(tid >> 6), fr = lane & 15, fq = lane >> 4;
    __syncthreads();
    for (int i = tid; i < 16 * 465; i += NTHREADS) sb[i] = p.na_rpb[i];
    const float NEG = -1e30f;
    const int kro = (fr >> 2) * 8 + (fr & 3);
    LAS unsigned char* kl = lds + fq * AT_KC + fr * 16;
    LAS unsigned char* vl = lds + AT_KBYTES + fq * 1040 + fr * 16;
#pragma unroll 1
    for (int vb = blockIdx.x; vb < 256; vb += gridDim.x) {
        const int half = vb & 1, h = (vb >> 1) & 15, b = vb >> 5;
        __syncthreads();
        {
            const int ctok = T_LAT + b * 256;
#pragma unroll
            for (int k = 0; k < 4; ++k) {
                const int ii = w * 4 + k, c = ii >> 2, q = ii & 3;
                const int rho = q * 64 + lane, g = rho >> 5, ts = (rho >> 4) & 1, f = rho & 15;
                const int key = g * 32 + (f >> 2) * 8 + ts * 4 + (f & 3);
                __builtin_amdgcn_global_load_lds((const unsigned*)(qk + (size_t)(ctok + key) * 2048 + 1024 + h * 64 + c * 8),
                                                 (LAS unsigned*)(lds + c * AT_KC + q * 1024), 16, 0, 0);
                const int vc = w * 4 + k;
                __builtin_amdgcn_global_load_lds((const unsigned*)(vT + (size_t)(h * 64 + lane) * T_ALL + ctok + vc * 8),
                                                 (LAS unsigned*)(lds + AT_KBYTES + vc * 1040), 16, 0, 0);
            }
            asm volatile("s_waitcnt vmcnt(0)" ::: "memory");
        }
        __syncthreads();
#pragma unroll 1
        for (int ul = w; ul < 136; ul += 8) {
            const bool isctx = ul >= 128;
            int r = 0, c0 = 0, qtok0;
            if (!isctx) { r = half * 32 + (ul >> 2); c0 = (ul & 3) * 16; qtok0 = b * 4096 + r * 64 + c0; }
            else { qtok0 = T_LAT + b * 256 + (half * 8 + (ul - 128)) * 16; }
            bf16x8 qf[2];
#pragma unroll
            for (int ks = 0; ks < 2; ++ks) qf[ks] = ld8(qk + (size_t)(qtok0 + fr) * 2048 + h * 64 + ks * 32 + fq * 8);
            const bf16_t* vrow = vT + (size_t)(h * 64 + fr) * T_ALL;
            float mL = NEG, lL = 0.f;
            f32x4 oL[4];
#pragma unroll
            for (int dt = 0; dt < 4; ++dt) oL[dt] = (f32x4){0.f, 0.f, 0.f, 0.f};
            if (!isctx) {
                f32x4 s[16];
                const int rs = min(max(r - 4, 0), 56), cst = min(max(c0 - 8, 0), 32);
#pragma unroll
                for (int i = 0; i < 8; ++i)
#pragma unroll
                    for (int ts = 0; ts < 2; ++ts) {
                        const size_t kt = (size_t)(b * 4096 + (rs + i) * 64 + cst + kro + ts * 4) * 2048 + 1024 + h * 64 + fq * 8;
                        f32x4 z = {0.f, 0.f, 0.f, 0.f};
                        z = mfma16(ld8(qk + kt), qf[0], z);
                        z = mfma16(ld8(qk + kt + 32), qf[1], z);
                        s[i * 2 + ts] = z;
                    }
                const int cq = c0 + fr, cs = min(max(cq - 8, 0), 48);
                const float* sbh = sb + h * 465 + (rs - r + 7) * 31;
#pragma unroll
                for (int i = 0; i < 8; ++i)
#pragma unroll
                    for (int ts = 0; ts < 2; ++ts)
#pragma unroll
                        for (int j = 0; j < 4; ++j) {
                            const int kc = cst + fq * 8 + ts * 4 + j;
                            const bool valid = (kc >= cs) && (kc < cs + 16);
                            const int ci = min(max(kc - cq + 15, 0), 30);
                            const float bias = sbh[i * 31 + ci];
                            s[i * 2 + ts][j] = valid ? s[i * 2 + ts][j] + bias : NEG;
                        }
                attn_block<false>(s, mL, lL, oL, vrow, b * 4096 + rs * 64 + cst, 64, fq, vl);
            }
            float mC, lC;
            f32x4 oC[4];
            {
                f32x4 s[16];
#pragma unroll
                for (int g = 0; g < 8; ++g)
#pragma unroll
                    for (int ts = 0; ts < 2; ++ts) {
                        f32x4 z = {0.f, 0.f, 0.f, 0.f};
                        z = mfma16(*(const LAS bf16x8*)(kl + (g * 32 + ts * 16) * 16), qf[0], z);
                        z = mfma16(*(const LAS bf16x8*)(kl + (g * 32 + ts * 16) * 16 + 4 * AT_KC), qf[1], z);
                        s[g * 2 + ts] = z;
                        if (ts == 1 && (g & 1)) __builtin_amdgcn_sched_barrier(0);
                    }
                attn_block<true>(s, mC, lC, oC, vrow, 0, 0, fq, vl);
            }
            const float m = fmaxf(mL, mC);
            const float eL = fexp(mL - m), eC = fexp(mC - m);
            const float inv = frcp(lL * eL + lC * eC);
            const float fL = eL * inv, fC = eC * inv;
#pragma unroll
            for (int dt = 0; dt < 4; ++dt) {
                u32x2 ov = {pack2(oL[dt][0] * fL + oC[dt][0] * fC, oL[dt][1] * fL + oC[dt][1] * fC),
                            pack2(oL[dt][2] * fL + oC[dt][2] * fC, oL[dt][3] * fL + oC[dt][3] * fC)};
                *reinterpret_cast<u32x2*>(ob + (size_t)(qtok0 + fr) * DM + h * 64 + dt * 16 + fq * 4) = ov;
            }
        }
    }
}

#define HC_QK 16640
#define HC_Q0 0
#define HC_K0 (3 * HC_QK)
#define HC_T0 (HC_K0 + 2 * HC_QK)
#define HC_V 8320
#define HC_VDB (HC_V + 512)
#define HC_VD0 (HC_T0 + 2 * 16384)
#define HC_P0 (HC_VD0 + 2 * HC_VDB)
__device__ __forceinline__ void hg_chain_phase(const Params& p, const bf16_t* qt, const bf16_t* kt, const bf16_t* vT, bf16_t* ob, char* smem) {
    if (blockIdx.x >= 256) return;
    LAS unsigned char* lds = (LAS unsigned char*)smem;
    const int tid = otid(), lane = tid & 63, w = __builtin_amdgcn_readfirstlane(tid >> 6), fr = lane & 15, fq = lane >> 4;
    const int chain = blockIdx.x >> 2, dvq = blockIdx.x & 3, dir = chain & 1, hh = (chain >> 1) & 3, b = chain >> 3;
    const bool is_owner = w < 2, is_helper = (w & 2) != 0;
    const int hw = (w & 1) | ((w >> 2) << 1);
    auto row0_of = [&](int i) { const int cidx = dir == 0 ? i : (i < 4 ? 3 - i : 67 - i); return cidx < 4 ? T_LAT + b * 256 + cidx * 64 : b * 4096 + (cidx - 4) * 64; };
    auto issue_qk = [&](int i, int qbuf, int kbuf) {
        const int row0 = row0_of(i);
        const bf16_t* qb = qt + ((size_t)dir * T_ALL + row0 + lane) * 512 + hh * 128;
        const bf16_t* kb = kt + ((size_t)dir * T_ALL + row0 + lane) * 512 + hh * 128;
#pragma unroll
        for (int k = 0; k < 2; ++k) {
            const int c = w + k * 8;
            __builtin_amdgcn_global_load_lds((const unsigned*)(qb + c * 8), (LAS unsigned*)(lds + HC_Q0 + qbuf * HC_QK + c * 1040), 16, 0, 0);
            __builtin_amdgcn_global_load_lds((const unsigned*)(kb + c * 8), (LAS unsigned*)(lds + HC_K0 + kbuf * HC_QK + c * 1040), 16, 0, 0);
        }
    };
    auto issue_vd = [&](int i, int buf) {
        const int row0 = row0_of(i);
        const bf16_t* vb = vT + (size_t)(hh * 128 + dvq * 32 + (lane & 31)) * T_ALL + row0;
        const int base = HC_VD0 + buf * HC_VDB;
        if (lane < 32) __builtin_amdgcn_global_load_lds((const unsigned*)(vb + w * 8), (LAS unsigned*)(lds + base + w * 1040), 16, 0, 0);
        if (tid < 32)
            __builtin_amdgcn_global_load_lds((const unsigned*)(p.dend + ((size_t)dir * 544 + (row0 >> 6)) * 512 + hh * 128 + tid * 4),
                                             (LAS unsigned*)(lds + base + HC_V), 16, 0, 0);
    };
    const int qlane = (fq >> 1) * 1040 + fr * 16 + (fq & 1) * 8;
    const int klane = (fq >> 1) * 1040 + (fr >> 2) * 128 + (fr & 3) * 16 + (fq & 1) * 8;
    const int glane = (fr >> 3) * 1040 + fq * 128 + (fr & 7) * 2;
    const int vlane = fq * 1040 + ((w & 1) * 16 + fr) * 16;
    const int plane = fq * 1040 + fr * 16;
    auto make_p = [&](int qb3, int kb2, int pb, int am, int att) {
        const bool askip = (dir == 0) ? (am == 1 && att < 2) : (am == 0 && att >= 2);
        if (askip) return;
        LAS unsigned char* Qb = lds + HC_Q0 + qb3 * HC_QK;
        LAS unsigned char* Kb = lds + HC_K0 + kb2 * HC_QK;
        f32x4 at[2];
        at[0] = (f32x4){0.f, 0.f, 0.f, 0.f}; at[1] = (f32x4){0.f, 0.f, 0.f, 0.f};
        bf16x8 qa[4];
        LAS unsigned char* qp = Qb + qlane + att * 256;
#pragma unroll
        for (int kk = 0; kk < 4; ++kk) {
            const u32x2 lo = *(const LAS u32x2*)(qp + (kk * 4) * 1040), hi = *(const LAS u32x2*)(qp + (kk * 4 + 2) * 1040);
            qa[kk] = mk8(lo[0], lo[1], hi[0], hi[1]);
        }
        LAS unsigned char* kp = Kb + klane + am * 512;
#pragma unroll
        for (int ts = 0; ts < 2; ++ts)
#pragma unroll
            for (int kk = 0; kk < 4; ++kk) {
                const u32x2 lo = *(const LAS u32x2*)(kp + ts * 64 + (kk * 4) * 1040), hi = *(const LAS u32x2*)(kp + ts * 64 + (kk * 4 + 2) * 1040);
                at[ts] = mfma16(mk8(lo[0], lo[1], hi[0], hi[1]), qa[kk], at[ts]);
            }
        const int t = att * 16 + fr;
        float pv[8];
#pragma unroll
        for (int ts = 0; ts < 2; ++ts)
#pragma unroll
            for (int j = 0; j < 4; ++j) {
                const int sidx = am * 32 + fq * 8 + ts * 4 + j;
                const bool valid = dir == 0 ? (sidx <= t) : (sidx >= t);
                pv[ts * 4 + j] = valid ? at[ts][j] : 0.f;
            }
        u32x4 pw = {pack2(pv[0], pv[1]), pack2(pv[2], pv[3]), pack2(pv[4], pv[5]), pack2(pv[6], pv[7])};
        *(LAS u32x4*)(lds + HC_P0 + pb * 8320 + plane + (am * 4) * 1040 + att * 256) = pw;
    };
    auto make_kt = [&](int kb2, int pb, int hidx) {
        LAS unsigned char* gp = lds + HC_K0 + kb2 * HC_QK + glane;
#pragma unroll
        for (int ff = 0; ff < 4; ++ff) {
            const int f = hidx * 4 + ff, dkt = f >> 1, k2 = f & 1;
            LAS unsigned char* g2 = gp + (dkt * 2) * 1040 + k2 * 512;
            unsigned e[8];
#pragma unroll
            for (int q = 0; q < 8; ++q) e[q] = *(const LAS bf16_t*)(g2 + q * 16);
            u32x4 kf = {e[0] | (e[1] << 16), e[2] | (e[3] << 16), e[4] | (e[5] << 16), e[6] | (e[7] << 16)};
            *(LAS u32x4*)(lds + HC_T0 + pb * 16384 + f * 1024 + lane * 16) = kf;
        }
    };
    f32x4 S[8];
#pragma unroll
    for (int i = 0; i < 8; ++i) S[i] = (f32x4){0.f, 0.f, 0.f, 0.f};
    __syncthreads();
    issue_qk(0, 0, 0); issue_qk(1, 1, 1); issue_vd(0, 0);
    asm volatile("s_waitcnt vmcnt(0)" ::: "memory");
    __syncthreads();
    make_p(0, 0, 0, 0, hw); make_p(0, 0, 0, 1, hw); make_kt(0, 0, hw);
    int q3 = 0;
#pragma unroll 1
    for (int i = 0; i < 68; ++i) {
        const int cur = i & 1;
        const int q3n = (q3 == 2) ? 0 : q3 + 1, q3nn = (q3n == 2) ? 0 : q3n + 1;
        asm volatile("s_waitcnt vmcnt(0)" ::: "memory");
        __syncthreads();
        if (i + 2 < 68) issue_qk(i + 2, q3nn, cur);
        if (i + 1 < 68) issue_vd(i + 1, cur ^ 1);
        if (is_helper) {
            if (i + 1 < 68) { make_p(q3n, cur ^ 1, cur ^ 1, 0, hw); make_p(q3n, cur ^ 1, cur ^ 1, 1, hw); make_kt(cur ^ 1, cur ^ 1, hw); }
        } else if (is_owner) {
            const int row0 = row0_of(i);
            LAS unsigned char* Qb = lds + HC_Q0 + q3 * HC_QK;
            LAS unsigned char* Tb = lds + HC_T0 + cur * 16384 + lane * 16;
            LAS unsigned char* Vb = lds + HC_VD0 + cur * HC_VDB;
            LAS unsigned char* Db = Vb + HC_V;
            LAS unsigned char* Pb = lds + HC_P0 + cur * 8320;
            f32x4 o[4];
            {
                bf16x8 sf[4];
#pragma unroll
                for (int kk = 0; kk < 4; ++kk)
                    sf[kk] = mk8(pack2(S[2 * kk][0], S[2 * kk][1]), pack2(S[2 * kk][2], S[2 * kk][3]),
                                 pack2(S[2 * kk + 1][0], S[2 * kk + 1][1]), pack2(S[2 * kk + 1][2], S[2 * kk + 1][3]));
                LAS unsigned char* qp = Qb + qlane;
#pragma unroll
                for (int tt = 0; tt < 4; ++tt) {
                    o[tt] = (f32x4){0.f, 0.f, 0.f, 0.f};
#pragma unroll
                    for (int kk = 0; kk < 4; ++kk) {
                        const u32x2 lo = *(const LAS u32x2*)(qp + tt * 256 + (kk * 4) * 1040), hi = *(const LAS u32x2*)(qp + tt * 256 + (kk * 4 + 2) * 1040);
                        o[tt] = mfma16(sf[kk], mk8(lo[0], lo[1], hi[0], hi[1]), o[tt]);
                    }
                }
            }
            bf16x8 vf[2];
#pragma unroll
            for (int m = 0; m < 2; ++m) vf[m] = *(const LAS bf16x8*)(Vb + vlane + (m * 4) * 1040);
#pragma unroll
            for (int m = 0; m < 2; ++m)
#pragma unroll
                for (int tt = 0; tt < 4; ++tt) {
                    const bool skip = (dir == 0) ? (m == 1 && tt < 2) : (m == 0 && tt >= 2);
                    if (!skip) {
                        const bf16x8 pf = *(const LAS bf16x8*)(Pb + plane + (m * 4) * 1040 + tt * 256);
                        o[tt] = mfma16(vf[m], pf, o[tt]);
                    }
                }
            bf16_t* op = ob + ((size_t)dir * T_ALL + row0) * 512 + hh * 128 + dvq * 32 + w * 16 + fq * 4;
#pragma unroll
            for (int tt = 0; tt < 4; ++tt) {
                u32x2 ov = {pack2(o[tt][0], o[tt][1]), pack2(o[tt][2], o[tt][3])};
                *reinterpret_cast<u32x2*>(op + (size_t)(tt * 16 + fr) * 512) = ov;
            }
#pragma unroll
            for (int dkt = 0; dkt < 8; ++dkt) {
#pragma unroll
                for (int k2 = 0; k2 < 2; ++k2)
                    S[dkt] = mfma16(*(const LAS bf16x8*)(Tb + (dkt * 2 + k2) * 1024), vf[k2], S[dkt]);
                const f32x4 dd = *(const LAS f32x4*)(Db + dkt * 64 + fq * 16);
                S[dkt][0] *= dd[0]; S[dkt][1] *= dd[1]; S[dkt][2] *= dd[2]; S[dkt][3] *= dd[3];
            }
        }
        q3 = q3n;
    }
}

__device__ __forceinline__ void hg_readout_phase(const Params& p, const bf16_t* ob, bf16_t* sg, int half) {
    const int tid_ = otid(); const int lane = tid_ & 63, w = tid_ >> 6;
    const int gw = blockIdx.x * 8 + w, nw = gridDim.x * 8;
    const float* ng = p.hg_norm_g + (lane & 15) * 8;
    f32x4 g0 = *reinterpret_cast<const f32x4*>(ng), g1 = *reinterpret_cast<const f32x4*>(ng + 4);
    for (int r = gw; r < T_ALL; r += nw) {
        u32x4 a = *reinterpret_cast<const u32x4*>(ob + (size_t)r * 512 + lane * 8);
        u32x4 bq = *reinterpret_cast<const u32x4*>(ob + ((size_t)T_ALL + r) * 512 + lane * 8);
        bf16_t* sp = sg + (size_t)r * DM + half * 512 + lane * 8;
        u32x4 gv = *reinterpret_cast<const u32x4*>(sp);
        float v[8];
#pragma unroll
        for (int i = 0; i < 4; ++i) { v[2 * i] = bflo(a[i]) + bflo(bq[i]); v[2 * i + 1] = bfhi(a[i]) + bfhi(bq[i]); }
        float ss = 0.f;
#pragma unroll
        for (int i = 0; i < 8; ++i) ss += v[i] * v[i];
        ss += __shfl_xor(ss, 1); ss += __shfl_xor(ss, 2); ss += __shfl_xor(ss, 4); ss += __shfl_xor(ss, 8);
        const float rstd = rsqrtf(ss * (1.0f / 128.0f) + EPSV);
        float gg[8] = {g0[0], g0[1], g0[2], g0[3], g1[0], g1[1], g1[2], g1[3]};
        float o[8];
#pragma unroll
        for (int i = 0; i < 4; ++i) {
            o[2 * i] = v[2 * i] * rstd * gg[2 * i] * bflo(gv[i]);
            o[2 * i + 1] = v[2 * i + 1] * rstd * gg[2 * i + 1] * bfhi(gv[i]);
        }
        u32x4 ov = {pack2(o[0], o[1]), pack2(o[2], o[3]), pack2(o[4], o[5]), pack2(o[6], o[7])};
        *reinterpret_cast<u32x4*>(sp) = ov;
    }
}

__global__ void __launch_bounds__(NTHREADS) fwd_megakernel(Params p, int ph0, int ph1) {
    extern __shared__ __attribute__((aligned(16))) char smem[];
    cg::grid_group grid = cg::this_grid();
    int ph = 0;
        volatile LAS unsigned* xst = (volatile LAS unsigned*)((LAS unsigned char*)smem + 150528);
    if (threadIdx.x == 0) { xst[0] = 0u; xst[1] = 0u; xst[2] = 0u; xst[3] = 0u; }
    __syncthreads();
    const XcdBarrier xb = xcd_barrier_post(p.bar, xst);
#define PHASE(...) { if (ph >= ph0 && ph < ph1) { __VA_ARGS__; if (ph + 1 < ph1) { if (ph == 0) grid.sync(); else xcd_barrier(xb); } } ++ph; }

    for (int r_ = 0; r_ < REP_P0; ++r_) PHASE(phase0(p, smem));

    bf16_t* const scr = reinterpret_cast<bf16_t*>(p.scr);
#pragma unroll 1
    for (int layer = 0; layer < 4; ++layer) {
        const int kind = layer % 3, slot = layer / 3;
        const bool need_ctx = layer < 3;
        const int Mall = T_ALL, Mpost = need_ctx ? T_ALL : T_LAT;
        const float* xin_lat = layer == 0 ? p.x : p.out;
        const float* xin_ctx = layer == 0 ? p.ctx : p.xctx;
        const float* modv_l = p.modv + (size_t)layer * 9 * 6144;
        if (layer == 0) PHASE(normmod_phase(p, xin_lat, xin_ctx, Mall, p.norm_mix_g + layer * DM, layer, 0));
        const bf16_t* mixout = nullptr;
        int mixK = 0;
        const bf16_t* wout = nullptr;
        if (kind == 0) {
            const bool ovl = (slot == 1) && gridDim.x > 160;
            bf16_t* hfw = ovl ? scr : p.hbuf;
            bf16_t* hbw = ovl ? p.spare : p.hbuf + (size_t)T_ALL * DRNN;
            bf16_t* gbuf = ovl ? scr + (size_t)T_ALL * DRNN : p.hbuf + (size_t)2 * T_ALL * DRNN;
            bf16_t* upre = ovl ? scr + (size_t)2 * T_ALL * DRNN : p.hbuf + (size_t)3 * T_ALL * DRNN;
            bf16_t* rec = hfw;
            if (ovl) { PHASE({ EpiLruIn e{nullptr, upre, 2}; gemm_phase(smem, p.hbuf, p.w_lin[slot] + (size_t)DRNN * DM, Mall, DRNN, DM, e); }); }
            else { PHASE({ EpiLruIn e{gbuf, upre, 0}; gemm_phase(smem, p.hbuf, p.w_lin[slot], Mall, 2560, DM, e); }); }
            for (int r_ = 0; r_ < REP_SCAN; ++r_) {
            PHASE(lru_scan_phase(p, slot, upre, hfw, hbw, smem, ovl ? p.hbuf : (const bf16_t*)nullptr, gbuf));
            }
            PHASE(lru_combine_phase(hfw, hbw, gbuf, Mpost));
            mixout = rec; mixK = DRNN; wout = p.w_lout[slot];
        } else if (kind == 1) {
            bf16_t* qk = scr;
            bf16_t* vT = scr + (size_t)T_ALL * 2048;
            bf16_t* ob = scr + (size_t)T_ALL * 3072;
            PHASE({ EpiQKV e{qk, vT, p.na_q_g, p.na_k_g}; gemm_phase(smem, p.hbuf, p.w_qkv, Mall, 3072, DM, e); });
            for (int r_ = 0; r_ < REP_ATTN; ++r_) PHASE(attn_phase(p, qk, vT, ob, smem));
            mixout = ob; mixK = DM; wout = p.w_nao;
        } else {
            bf16_t* qt = scr;
            bf16_t* kt = scr + (size_t)T_ALL * 1024;
            bf16_t* vT = scr + (size_t)T_ALL * 2048;
            bf16_t* ob = scr + (size_t)T_ALL * 2560;
            bf16_t* sg = scr + (size_t)T_ALL * 3584;
            for (int half = 0; half < 2; ++half) {
                PHASE({ EpiHg e{qt, kt, sg, vT, p.dend, p.lbv, half}; gemm_phase(smem, p.hbuf, p.w_hg + (size_t)half * 2560 * DM, Mall, 2560, DM, e); });
                for (int r_ = 0; r_ < REP_CHAIN; ++r_) PHASE(hg_chain_phase(p, qt, kt, vT, ob, smem));
                PHASE(hg_readout_phase(p, ob, sg, half));
            }
            mixout = sg; mixK = DM; wout = p.w_hgo;
        }
        const bool split = need_ctx && gridDim.x > 64;
        PHASE({ EpiResid e{xin_lat, xin_ctx, p.out, p.xctx, modv_l, 2}; gemm_phase(smem, mixout, wout, split ? T_LAT : Mpost, DM, mixK, e); });
        if (split) {
            PHASE({
                if (blockIdx.x < 32) { EpiResid e{xin_lat, xin_ctx, p.out, p.xctx, modv_l, 2}; gemm_phase(smem, mixout + (size_t)T_LAT * mixK, wout, T_CTX, DM, mixK, e, 32, (int)blockIdx.x, 128); }
                else normmod_phase(p, p.out, p.xctx, T_LAT, p.norm_ffn_g + layer * DM, layer, 3, 0, (int)blockIdx.x - 32, (int)gridDim.x - 32);
            });
            PHASE(normmod_phase(p, p.out, p.xctx, T_ALL, p.norm_ffn_g + layer * DM, layer, 3, T_LAT));
        } else {
            PHASE(normmod_phase(p, p.out, p.xctx, Mpost, p.norm_ffn_g + layer * DM, layer, 3));
        }
        bf16_t* ffh = scr;
        PHASE({ EpiSwiglu e{ffh}; gemm_phase(smem, p.hbuf, p.w_gu[layer], Mpost, 2 * DFF, DM, e); });
        PHASE({ EpiResid e{p.out, p.xctx, p.out, p.xctx, modv_l, 5}; gemm_phase(smem, ffh, p.w_dn[layer], split ? T_LAT : Mpost, DM, DFF, e); });
        if (layer < 3) {
            const float* gnext = p.norm_mix_g + (layer + 1) * DM;
            if (split) {
                PHASE({
                    if (blockIdx.x < 32) { EpiResid e{p.out, p.xctx, p.out, p.xctx, modv_l, 5}; gemm_phase(smem, ffh + (size_t)T_LAT * DFF, p.w_dn[layer], T_CTX, DM, DFF, e, 32, (int)blockIdx.x, 128); }
                    else normmod_phase(p, p.out, p.xctx, T_LAT, gnext, layer + 1, 0, 0, (int)blockIdx.x - 32, (int)gridDim.x - 32);
                });
                PHASE(normmod_phase(p, p.out, p.xctx, T_ALL, gnext, layer + 1, 0, T_LAT));
            } else {
                PHASE(normmod_phase(p, p.out, p.xctx, T_ALL, gnext, layer + 1, 0));
            }
        }
    }
}
#define N_PHASES 41

static inline size_t al256(size_t v) { return (v + 255) & ~(size_t)255; }

extern "C" void kernel_launch(void* const* d_in, const int* in_sizes, int n_in, void* d_out, int out_size, void* d_ws, size_t ws_size,
                              hipStream_t stream) {
    (void)in_sizes; (void)n_in; (void)out_size; (void)ws_size;
    Params p;
    memset(&p, 0, sizeof(p));
    const float* const* in = reinterpret_cast<const float* const*>(d_in);
    p.x = in[0]; p.c = in[1]; p.ctx = in[2]; p.c_ctx = in[3]; p.mod_w = in[4]; p.mod_b = in[5]; p.norm_mix_g = in[6]; p.norm_ffn_g = in[7];
    const float* ffn_w_gu = in[8]; const float* ffn_w_down = in[9]; const float* lru_w_in = in[10];
    p.lru_conv_w = in[11]; p.lru_conv_b = in[12];
    const float* lru_gate_w = in[13];
    p.lru_gate_b = in[14]; p.lru_lambda = in[15];
    const float* lru_w_out = in[16]; const float* na_w_qkv = in[17];
    p.na_q_g = in[18]; p.na_k_g = in[19]; p.na_rpb = in[20];
    const float* na_w_o = in[21]; const float* hg_w_in = in[22];
    p.hg_lb_logits = in[23]; p.hg_norm_g = in[24];
    const float* hg_w_o = in[25];
    p.out = reinterpret_cast<float*>(d_out);

    char* ws = reinterpret_cast<char*>(d_ws);
    size_t off = 0;
    p.xctx = reinterpret_cast<float*>(ws + off); off += al256((size_t)T_CTX * DM * 4);
    p.modv = reinterpret_cast<float*>(ws + off); off += al256((size_t)4 * 9 * 6144 * 4);
    p.lbv = reinterpret_cast<float*>(ws + off); off += al256(1024 * 4);
    p.dend = reinterpret_cast<float*>(ws + off); off += al256((size_t)2 * 544 * 512 * 4);
    p.bar = reinterpret_cast<unsigned*>(ws + off); off += al256((size_t)XCD_BAR_WORDS * 4);
    p.spare = reinterpret_cast<bf16_t*>(ws + off); off += al256((size_t)2 * 2 * 8 * 68 * DRNN * 4);
    bf16_t* wt = reinterpret_cast<bf16_t*>(ws + off);
    size_t woff = 0;
    int nj = 0, tiles = 0;
    auto addjob = [&](const float* src, int K, int ld, int nrows, int mode, int nbatch, long sbs, long dbs) -> const bf16_t* {
        bf16_t* dst = wt + woff;
        ConvJob& j = p.jobs[nj++];
        j.src = src; j.dst = dst; j.K = K; j.ld = ld; j.nrows = nrows; j.mode = mode; j.nbatch = nbatch; j.tile0 = tiles; j.sbs = sbs; j.dbs = dbs;
        tiles += (K / 64) * (nrows / 64) * nbatch;
        woff += (size_t)K * nrows * nbatch;
        return dst;
    };
    p.w_lin[0] = addjob(lru_w_in, DM, 2560, 2560, 0, 1, 0, 0);
    p.w_lout[0] = addjob(lru_w_out, DRNN, DM, DM, 0, 1, 0, 0);
    p.w_gate[0] = addjob(lru_gate_w, 128, 128, 128, 0, 40, 16384, 16384);
    p.w_gu[0] = addjob(ffn_w_gu, DM, 2 * DFF, 2 * DFF, 1, 1, 0, 0);
    p.w_dn[0] = addjob(ffn_w_down, DFF, DM, DM, 0, 1, 0, 0);
    p.conv_tiles_first = tiles;
    for (int l = 1; l < 3; ++l) {
        p.w_gu[l] = addjob(ffn_w_gu + (size_t)l * DM * 2 * DFF, DM, 2 * DFF, 2 * DFF, 1, 1, 0, 0);
        p.w_dn[l] = addjob(ffn_w_down + (size_t)l * DFF * DM, DFF, DM, DM, 0, 1, 0, 0);
    }
    p.w_qkv = addjob(na_w_qkv, DM, 3072, 3072, 3, 1, 0, 0);
    p.w_nao = addjob(na_w_o, DM, DM, DM, 0, 1, 0, 0);
    p.w_hg = addjob(hg_w_in, DM, 5120, 5120, 2, 1, 0, 0);
    p.w_hgo = addjob(hg_w_o, DM, DM, DM, 0, 1, 0, 0);
    p.w_gu[3] = addjob(ffn_w_gu + (size_t)3 * DM * 2 * DFF, DM, 2 * DFF, 2 * DFF, 1, 1, 0, 0);
    p.w_dn[3] = addjob(ffn_w_down + (size_t)3 * DFF * DM, DFF, DM, DM, 0, 1, 0, 0);
    p.w_lin[1] = addjob(lru_w_in + (size_t)DM * 2560, DM, 2560, 2560, 0, 1, 0, 0);
    p.w_lout[1] = addjob(lru_w_out + (size_t)DRNN * DM, DRNN, DM, DM, 0, 1, 0, 0);
    p.w_gate[1] = addjob(lru_gate_w + (size_t)40 * 16384, 128, 128, 128, 0, 40, 16384, 16384);
    p.total_conv_tiles = tiles;
    off += al256(woff * 2);
    p.hbuf = reinterpret_cast<bf16_t*>(ws + off); off += al256((size_t)T_ALL * DM * 2);
    p.scr = ws + off;

    constexpr size_t kDynLds = 150528 + 16;
    static int grid_blocks = 0;
    if (!grid_blocks) {
        int dev = 0, cus = 0, per_cu = 0;
        hipGetDevice(&dev);
        hipDeviceGetAttribute(&cus, hipDeviceAttributeMultiprocessorCount, dev);
        hipFuncSetAttribute((const void*)fwd_megakernel, hipFuncAttributeMaxDynamicSharedMemorySize, (int)kDynLds);
        hipOccupancyMaxActiveBlocksPerMultiprocessor(&per_cu, fwd_megakernel, NTHREADS, kDynLds);
        if (per_cu < 1) per_cu = 1;
        grid_blocks = cus;
        (void)per_cu;
    }
#ifdef MULTI_LAUNCH
    for (int ph = 0; ph < N_PHASES; ++ph) {
        int a = ph, b = ph + 1;
        void* args[] = {&p, &a, &b};
        hipLaunchCooperativeKernel((void*)fwd_megakernel, dim3(grid_blocks), dim3(NTHREADS), args, kDynLds, stream);
    }
#else
    hipMemsetAsync(p.bar, 0, (size_t)XCD_BAR_WORDS * 4, stream);
    int a = 0, b = N_PHASES;
    void* args[] = {&p, &a, &b};
    hipError_t e = hipLaunchCooperativeKernel((void*)fwd_megakernel, dim3(grid_blocks), dim3(NTHREADS), args, kDynLds, stream);
    if (e != hipSuccess) fprintf(stderr, "cooperative launch failed: %s (grid %d)\n", hipGetErrorString(e), grid_blocks);
#endif
}
```
